# Optimizing an MI355X kernel written in HIP

```python
import math, functools
import jax, jax.numpy as jnp
from jax import lax
import numpy as np

D_MODEL = 4096
BATCH = 2
SEQ = 8192
DEPTH = 1

MEM_LEN = 256
MEM_HEADS = 4
MEM_HEAD_DIM = 256
LRU_WIDTH = D_MODEL
LRU_HEADS = 16
LRU_BLOCK_W = LRU_WIDTH // LRU_HEADS
CONV_WIDTH = 4
LRU_C = 8.0
MLA_HEADS = 32
QK_NOPE = 128
QK_ROPE = 64
V_HEAD = 128
Q_LORA = 1024
KV_LORA = 512
ROPE_THETA = 10000.0
Q_BLOCK = 128
D_FF = -(-8 * D_MODEL // (3 * 256)) * 256
EPS = 1e-6

IN_SPLITS = (LRU_WIDTH, LRU_WIDTH, Q_LORA, KV_LORA, QK_ROPE, D_MODEL, D_MODEL)
IN_COLS = sum(IN_SPLITS)

kernel_name = "hybrid_rglru_mla_memory_encoder"


def _rmsnorm(t, g):
    t32 = t.astype(jnp.float32)
    inv = lax.rsqrt(jnp.mean(t32 * t32, axis=-1, keepdims=True) + EPS)
    return (t32 * inv * g.astype(jnp.float32)).astype(t.dtype)


def _split_cols(t, sizes):
    idx = np.cumsum(sizes)[:-1].tolist()
    return jnp.split(t, idx, axis=-1)


def _rope_tables(positions):
    inv_freq = ROPE_THETA ** (-jnp.arange(0, QK_ROPE, 2, dtype=jnp.float32) / QK_ROPE)
    ang = positions.astype(jnp.float32)[..., None] * inv_freq
    return jnp.cos(ang)[:, :, None, :], jnp.sin(ang)[:, :, None, :]


def _apply_rope(t, cos, sin):
    t32 = t.astype(jnp.float32)
    t1, t2 = jnp.split(t32, 2, axis=-1)
    return jnp.concatenate([t1 * cos - t2 * sin, t2 * cos + t1 * sin], axis=-1).astype(t.dtype)


def _depthwise_conv_centred(t, w, b):
    left = CONV_WIDTH // 2
    right = CONV_WIDTH - 1 - left
    s = t.shape[1]
    tp = jnp.pad(t, ((0, 0), (left, right), (0, 0)))
    out = b.astype(t.dtype)
    for k in range(CONV_WIDTH):
        out = out + tp[:, k:k + s] * w[k]
    return out


def _scan_combine(c1, c2):
    a1, b1 = c1
    a2, b2 = c2
    return a1 * a2, a2 * b1 + b2


def _rg_lru(xc, wa, ba, wx, bx, lam, reverse):
    bsz, s, w = xc.shape
    xb = xc.reshape(bsz, s, LRU_HEADS, LRU_BLOCK_W)
    r = jax.nn.sigmoid(jnp.einsum('bsnd,nde->bsne', xb, wa) + ba).reshape(bsz, s, w)
    i = jax.nn.sigmoid(jnp.einsum('bsnd,nde->bsne', xb, wx) + bx).reshape(bsz, s, w)
    log_a = LRU_C * r.astype(jnp.float32) * jax.nn.log_sigmoid(lam.astype(jnp.float32))
    a = jnp.exp(log_a)
    mult = jnp.sqrt(-jnp.expm1(2.0 * log_a))
    pos = jnp.arange(s)
    first = (pos == (s - 1)) if reverse else (pos == 0)
    mult = jnp.where(first[None, :, None], 1.0, mult)
    bterm = mult * (i * xc).astype(jnp.float32)
    _, h = lax.associative_scan(_scan_combine, (a, bterm), reverse=reverse, axis=1)
    return h.astype(xc.dtype)


def _mla_attention(q, k, v):
    bsz, s, h, dqk = q.shape
    nblk = s // Q_BLOCK
    q = q * jnp.asarray((QK_NOPE + QK_ROPE) ** -0.5, q.dtype)
    qb = q.reshape(bsz, nblk, Q_BLOCK, h, dqk).transpose(1, 0, 2, 3, 4)

    def one_block(q_blk):
        sc = jnp.einsum('bqhd,bkhd->bhqk', q_blk, k, preferred_element_type=jnp.float32)
        p = jax.nn.softmax(sc, axis=-1)
        return jnp.einsum('bhqk,bkhd->bqhd', p.astype(v.dtype), v)

    o = lax.map(one_block, qb)
    return o.transpose(1, 0, 2, 3, 4).reshape(bsz, s, h * V_HEAD)


def setup_inputs(seed: int = 0) -> dict:
    key = jax.random.key(seed)
    ks = iter(jax.random.split(key, 48))
    L = DEPTH

    def nrm(shape, scale):
        return jax.random.normal(next(ks), shape, jnp.float32) * scale

    def gain(shape):
        return 1.0 + 0.01 * jax.random.normal(next(ks), shape, jnp.float32)

    def lru_lambda():
        a8 = jax.random.uniform(next(ks), (L, LRU_WIDTH), jnp.float32, 0.9, 0.999)
        a = a8 ** (1.0 / LRU_C)
        return jnp.log(a) - jnp.log1p(-a)

    x = jax.random.normal(next(ks), (BATCH, SEQ, D_MODEL), jnp.float32)
    mem = jax.random.normal(next(ks), (BATCH, MEM_LEN, D_MODEL), jnp.float32)
    offset = jax.random.randint(next(ks), (BATCH, 1), 0, 4096, dtype=jnp.int32)
    positions = offset + jnp.arange(SEQ, dtype=jnp.int32)[None, :]
    bw = LRU_BLOCK_W ** -0.5
    return {
        "x": x,
        "mem": mem,
        "positions": positions,
        "norm_mix": gain((L, D_MODEL)),
        "w_in": nrm((L, D_MODEL, IN_COLS), D_MODEL ** -0.5),
        "conv_w": nrm((L, CONV_WIDTH, LRU_WIDTH), CONV_WIDTH ** -0.5),
        "conv_b": nrm((L, LRU_WIDTH), 0.01),
        "lru_wa_f": nrm((L, LRU_HEADS, LRU_BLOCK_W, LRU_BLOCK_W), bw),
        "lru_ba_f": nrm((L, LRU_HEADS, LRU_BLOCK_W), 0.01),
        "lru_wx_f": nrm((L, LRU_HEADS, LRU_BLOCK_W, LRU_BLOCK_W), bw),
        "lru_bx_f": nrm((L, LRU_HEADS, LRU_BLOCK_W), 0.01),
        "lru_lam_f": lru_lambda(),
        "lru_wa_b": nrm((L, LRU_HEADS, LRU_BLOCK_W, LRU_BLOCK_W), bw),
        "lru_ba_b": nrm((L, LRU_HEADS, LRU_BLOCK_W), 0.01),
        "lru_wx_b": nrm((L, LRU_HEADS, LRU_BLOCK_W, LRU_BLOCK_W), bw),
        "lru_bx_b": nrm((L, LRU_HEADS, LRU_BLOCK_W), 0.01),
        "lru_lam_b": lru_lambda(),
        "q_a_norm": gain((L, Q_LORA)),
        "w_uq": nrm((L, Q_LORA, MLA_HEADS * (QK_NOPE + QK_ROPE)), Q_LORA ** -0.5),
        "kv_a_norm": gain((L, KV_LORA)),
        "w_ukv": nrm((L, KV_LORA, MLA_HEADS * (QK_NOPE + V_HEAD)), KV_LORA ** -0.5),
        "w_proj_lru": nrm((L, LRU_WIDTH, D_MODEL), LRU_WIDTH ** -0.5),
        "w_proj_mla": nrm((L, MLA_HEADS * V_HEAD, D_MODEL), (MLA_HEADS * V_HEAD) ** -0.5),
        "w_out": nrm((L, D_MODEL, D_MODEL), D_MODEL ** -0.5),
        "norm_mem_x": gain((L, D_MODEL)),
        "norm_mem_kv": gain((L, D_MODEL)),
        "w_mem_q": nrm((L, D_MODEL, MEM_HEADS * MEM_HEAD_DIM), D_MODEL ** -0.5),
        "w_mem_kv": nrm((L, D_MODEL, 2 * MEM_HEADS * MEM_HEAD_DIM), D_MODEL ** -0.5),
        "w_mem_o": nrm((L, MEM_HEADS * MEM_HEAD_DIM, D_MODEL), (MEM_HEADS * MEM_HEAD_DIM) ** -0.5),
        "norm_ffn": gain((L, D_MODEL)),
        "w_ffn_gate": nrm((L, D_MODEL, D_FF), D_MODEL ** -0.5),
        "w_ffn_up": nrm((L, D_MODEL, D_FF), D_MODEL ** -0.5),
        "w_ffn_down": nrm((L, D_FF, D_MODEL), D_FF ** -0.5),
        "norm_final": gain((D_MODEL,)),
    }


def reference(x, mem, positions, norm_mix, w_in, conv_w, conv_b,
              lru_wa_f, lru_ba_f, lru_wx_f, lru_bx_f, lru_lam_f,
              lru_wa_b, lru_ba_b, lru_wx_b, lru_bx_b, lru_lam_b,
              q_a_norm, w_uq, kv_a_norm, w_ukv,
              w_proj_lru, w_proj_mla, w_out,
              norm_mem_x, norm_mem_kv, w_mem_q, w_mem_kv, w_mem_o,
              norm_ffn, w_ffn_gate, w_ffn_up, w_ffn_down, norm_final):
    bsz, s, _ = x.shape
    cos, sin = _rope_tables(positions)

    for l in range(DEPTH):
        h = _rmsnorm(x, norm_mix[l])
        proj = h @ w_in[l]
        xa, ga, cq, ckv, krope, gate_a, gate_b = _split_cols(proj, IN_SPLITS)

        xc = _depthwise_conv_centred(xa, conv_w[l], conv_b[l])
        y_lru = (_rg_lru(xc, lru_wa_f[l], lru_ba_f[l], lru_wx_f[l], lru_bx_f[l], lru_lam_f[l], False)
                 + _rg_lru(xc, lru_wa_b[l], lru_ba_b[l], lru_wx_b[l], lru_bx_b[l], lru_lam_b[l], True))
        y_a = jax.nn.gelu(ga) * y_lru

        q = (_rmsnorm(cq, q_a_norm[l]) @ w_uq[l]).reshape(bsz, s, MLA_HEADS, QK_NOPE + QK_ROPE)
        q_nope, q_rope = jnp.split(q, [QK_NOPE], axis=-1)
        q_rope = _apply_rope(q_rope, cos, sin)
        kv = (_rmsnorm(ckv, kv_a_norm[l]) @ w_ukv[l]).reshape(bsz, s, MLA_HEADS, QK_NOPE + V_HEAD)
        k_nope, v = jnp.split(kv, [QK_NOPE], axis=-1)
        k_rope = _apply_rope(krope[:, :, None, :], cos, sin)
        k_rope = jnp.broadcast_to(k_rope, (bsz, s, MLA_HEADS, QK_ROPE))
        qh = jnp.concatenate([q_nope, q_rope], axis=-1)
        kh = jnp.concatenate([k_nope, k_rope], axis=-1)
        y_b = _mla_attention(qh, kh, v)

        merged = (jax.nn.sigmoid(gate_a) * (y_a @ w_proj_lru[l])
                  + jax.nn.sigmoid(gate_b) * (y_b @ w_proj_mla[l]))
        x = x + merged @ w_out[l]

        hq = _rmsnorm(x, norm_mem_x[l])
        hm = _rmsnorm(mem, norm_mem_kv[l])
        mq = (hq @ w_mem_q[l]).reshape(bsz, s, MEM_HEADS, MEM_HEAD_DIM)
        mk, mv = jnp.split((hm @ w_mem_kv[l]).reshape(bsz, -1, MEM_HEADS, 2 * MEM_HEAD_DIM), 2, axis=-1)
        sc = jnp.einsum('bqhd,bkhd->bhqk', mq * jnp.asarray(MEM_HEAD_DIM ** -0.5, mq.dtype), mk,
                        preferred_element_type=jnp.float32)
        p = jax.nn.softmax(sc, axis=-1).astype(mv.dtype)
        mo = jnp.einsum('bhqk,bkhd->bqhd', p, mv).reshape(bsz, s, MEM_HEADS * MEM_HEAD_DIM)
        x = x + mo @ w_mem_o[l]

        hf = _rmsnorm(x, norm_ffn[l])
        x = x + (jax.nn.silu(hf @ w_ffn_gate[l]) * (hf @ w_ffn_up[l])) @ w_ffn_down[l]

    return _rmsnorm(x, norm_final)
```

```cpp
#include <hip/hip_runtime.h>
#include <cstdio>
#include <cstdint>

#define LAS __attribute__((address_space(3)))
#define GAS __attribute__((address_space(1)))
typedef unsigned short bf16_t;
typedef short bf16x8 __attribute__((ext_vector_type(8)));
typedef short s16x4 __attribute__((ext_vector_type(4)));
typedef float f32x2 __attribute__((ext_vector_type(2)));
typedef float f32x4 __attribute__((ext_vector_type(4)));
typedef float f32x16 __attribute__((ext_vector_type(16)));
typedef unsigned u32x2 __attribute__((ext_vector_type(2)));
typedef unsigned u32x4 __attribute__((ext_vector_type(4)));

#ifndef MK_PER_PHASE
#define MK_PER_PHASE 0
#endif

constexpr int BATCH = 2, SEQ = 8192, DM = 4096, M = BATCH * SEQ;
constexpr int NH = 32, DFF = 11008;
constexpr int IN_COLS = 17984, IN_PAD = 18176;
constexpr float EPS = 1e-6f;
constexpr int NWAVES = 8;
constexpr int NPHASE = 18;
constexpr int SCAN_L = 128, SCAN_NC = SEQ / SCAN_L;

constexpr size_t MiB = 1u << 20;
constexpr size_t WS_CTL = 0, CTL_ZERO_BYTES = 1 * MiB;
constexpr size_t WS_CS = 1 * MiB;
constexpr size_t WS_HM = 5 * MiB;
constexpr size_t WS_MK = 9 * MiB;
constexpr size_t WS_MV = 10 * MiB;
constexpr size_t WS_INVQ = 11 * MiB;
constexpr size_t WS_INVKV = 11 * MiB + 256 * 1024;
constexpr size_t WS_C2 = 11 * MiB + 512 * 1024;
constexpr size_t WS_AGG = 12 * MiB;
constexpr size_t WS_PART1 = 20 * MiB, WS_PART2 = 24 * MiB;
constexpr size_t WS_W = 33 * MiB;
constexpr size_t WS_WIN = WS_W;
constexpr size_t WS_WG = WS_WIN + 142 * MiB;
constexpr size_t WS_WUQ = WS_WG + 8 * MiB;
constexpr size_t WS_WUKV = WS_WUQ + 12 * MiB;
constexpr size_t WS_WPL = WS_WUKV + 8 * MiB;
constexpr size_t WS_WPM = WS_WPL + 32 * MiB;
constexpr size_t WS_WO = WS_WPM + 32 * MiB;
constexpr size_t WS_WMQ = WS_WO + 32 * MiB;
constexpr size_t WS_WMKV = WS_WMQ + 8 * MiB;
constexpr size_t WS_WMO = WS_WMKV + 16 * MiB;
constexpr size_t WS_WGU = WS_WMO + 8 * MiB;
constexpr size_t WS_WD = WS_WGU + 172 * MiB;
constexpr size_t WS_A0 = WS_WD + 86 * MiB;
constexpr size_t PLANE = 128 * MiB;
constexpr size_t WS_A1 = WS_A0 + PLANE, WS_A2 = WS_A1 + PLANE, WS_A3 = WS_A2 + PLANE, WS_A4 = WS_A3 + PLANE, WS_A5 = WS_A4 + PLANE;
constexpr size_t WS_END = WS_A5 + PLANE;
static_assert(WS_A0 == 589 * MiB && WS_END == 1357 * MiB, "ws map");
constexpr size_t DO_D0 = 0, DO_D1 = PLANE;
constexpr size_t DO_CQ = DO_D1, DO_CKV = DO_D1 + 32 * MiB, DO_KRP = DO_D1 + 48 * MiB, DO_KR = DO_D1 + 50 * MiB, DO_QR = DO_D1 + 64 * MiB;

constexpr int CW_BAR = 4096, CW_SUB = 8192;

constexpr int RING_BYTES = 131072;
constexpr int LDSCTL_OFF = RING_BYTES, MISC_OFF = LDSCTL_OFF + 320;
constexpr int LDS_BYTES = 147456;

__device__ const float INV_FREQ[32] = {
    1.000000000e+00f, 7.498942018e-01f, 5.623413324e-01f, 4.216965139e-01f, 3.162277639e-01f, 2.371373773e-01f, 1.778279394e-01f, 1.333521456e-01f,
    1.000000015e-01f, 7.498942316e-02f, 5.623413250e-02f, 4.216964915e-02f, 3.162277490e-02f, 2.371373773e-02f, 1.778279431e-02f, 1.333521400e-02f,
    9.999999776e-03f, 7.498942316e-03f, 5.623413250e-03f, 4.216964822e-03f, 3.162277630e-03f, 2.371373819e-03f, 1.778279431e-03f, 1.333521446e-03f,
    1.000000047e-03f, 7.498941850e-04f, 5.623413017e-04f, 4.216965172e-04f, 3.162277571e-04f, 2.371373703e-04f, 1.778279402e-04f, 1.333521504e-04f};

typedef __bf16 bf16x2_t __attribute__((ext_vector_type(2)));
__device__ __forceinline__ unsigned cvt_pk_bf16(float lo, float hi) { const f32x2 v = {lo, hi}; const bf16x2_t b = __builtin_convertvector(v, bf16x2_t); return __builtin_bit_cast(unsigned, b); }
__device__ __forceinline__ float bf_lo(unsigned w) { return __uint_as_float(w << 16); }
__device__ __forceinline__ float bf_hi(unsigned w) { return __uint_as_float(w & 0xffff0000u); }
__device__ __forceinline__ float bf2f(bf16_t b) { return __uint_as_float((unsigned)b << 16); }
__device__ __forceinline__ unsigned f2bf(float f) { unsigned u = __builtin_bit_cast(unsigned, f); return (u + 0x7fffu + ((u >> 16) & 1u)) >> 16; }
__device__ __forceinline__ unsigned pk2(float lo, float hi) { return f2bf(lo) | (f2bf(hi) << 16); }
__device__ __forceinline__ float sigm(float z) { return __builtin_amdgcn_rcpf(1.f + __builtin_amdgcn_exp2f(-1.4426950408889634f * z)); }
__device__ __forceinline__ f32x4 mult_of(const f32x4 a) {
    f32x4 m;
#pragma unroll
    for (int i = 0; i < 4; ++i) m[i] = __builtin_amdgcn_sqrtf(fmaxf(1.f - a[i] * a[i], 0.f));
    return m; }
__device__ __forceinline__ float gelu_tanh(float x) { const float u = 0.7978845608028654f * (x + 0.044715f * x * x * x); return x * sigm(2.f * u); }
__device__ __forceinline__ float silu(float x) { return x * sigm(x); }
__device__ __forceinline__ float wave_sum(float v) {
#pragma unroll
    for (int o = 1; o < 64; o <<= 1) v += __shfl_xor(v, o);
    return v;
}
__device__ __forceinline__ int lane_id() { int l; asm volatile("v_mbcnt_lo_u32_b32 %0, -1, 0\n\tv_mbcnt_hi_u32_b32 %0, -1, %0" : "=v"(l)); return l; }
__device__ __forceinline__ int fresh_tid(int wave) { int t = wave * 64 + lane_id(); asm volatile("" : "+v"(t)); return t; }
#define LDS_WAIT() asm volatile("s_waitcnt lgkmcnt(0)" ::: "memory")
#define VM_WAIT() asm volatile("s_waitcnt vmcnt(0)" ::: "memory")

namespace pg8 {
constexpr int BM = 256, BK = 64, HALF = 128, HTB = HALF * BK * 2, STAGE_BYTES = 8 * HTB, NXCD = 8, WGM = 8;
__host__ __device__ __forceinline__ int lds_byte(int r, int c) { const int st = (r >> 4) * 2 + (c >> 5), rr = r & 15, cc = c & 31, ob = rr * 64 + cc * 2; return st * 1024 + (ob ^ (((ob >> 9) & 1) << 5)); }
__host__ __device__ __forceinline__ void stage_rc(int b, int& R, int& C) { const int st = b / 1024, sb = b % 1024, swz = sb ^ (((sb >> 9) & 1) << 5); R = (st >> 1) * 16 + swz / 64; C = (st & 1) * 32 + (swz % 64) / 2; }
__host__ __device__ __forceinline__ int perm32(int rho) { const int n = rho >> 4, i = rho & 15; return 8 * (i >> 2) + 4 * n + (i & 3); }

struct Unit { int pm, pn; };
struct Gemm { const bf16_t* A; const bf16_t* Bt; int M, N, K, lda, ldb, a_shift, a_mask; };

struct StaticOrder {
    int nM, nN, nwg, G, c;
    __host__ __device__ void init(int M_, int N_, int G_, int c_) { nM = M_ / BM; nN = N_ / BM; nwg = nM * nN; G = G_; c = c_; }
    __host__ __device__ bool next(int i, Unit& u) const {
        const long L = (long)i * G + c; if (L >= nwg) return false;
        int wgid = (int)L; { const int q = nwg / NXCD, r = nwg % NXCD, xcd = wgid % NXCD, off = wgid / NXCD; wgid = (xcd < r ? xcd * (q + 1) : r * (q + 1) + (xcd - r) * q) + off; }
        const int nig = WGM * nN, gid = wgid / nig, fm = gid * WGM, gsz = (nM - fm) < WGM ? (nM - fm) : WGM;
        u.pm = fm + ((wgid % nig) % gsz); u.pn = (wgid % nig) / gsz; return true;
    }
};

typedef f32x4 Acc[2][2][4][2];

__device__ __forceinline__ u32x4 pack8(f32x4 v0, f32x4 v1) { u32x4 w; w.x = cvt_pk_bf16(v0[0], v0[1]); w.y = cvt_pk_bf16(v0[2], v0[3]); w.z = cvt_pk_bf16(v1[0], v1[1]); w.w = cvt_pk_bf16(v1[2], v1[3]); return w; }

template <int ACT  >
__device__ __forceinline__ void store_tile_bf16(const Acc& acc, bf16_t* dst, int ldc, int colt, int ncol, int pm, int wr, int wc, int fr, int fq, const float* rowscale) {
    const int row0 = pm * BM + wr * 64 + fr, cl = wc * 32 + 8 * fq;
#pragma unroll
    for (int ai = 0; ai < 2; ++ai)
#pragma unroll
        for (int m = 0; m < 4; ++m) { const int row = row0 + ai * HALF + m * 16; bf16_t* rowp = dst + (size_t)row * ldc + colt + cl;
            const float rs = rowscale ? rowscale[row] : 1.f;
#pragma unroll
            for (int bj = 0; bj < 2; ++bj) { if (bj * HALF + cl < ncol) { f32x4 v0 = acc[ai][bj][m][0], v1 = acc[ai][bj][m][1];
                if (ACT == 1) {
#pragma unroll
                    for (int i = 0; i < 4; ++i) { v0[i] = gelu_tanh(v0[i]); v1[i] = gelu_tanh(v1[i]); } }
                if (ACT == 2) {
#pragma unroll
                    for (int i = 0; i < 4; ++i) { v0[i] = sigm(v0[i]); v1[i] = sigm(v1[i]); } }
                v0 = v0 * rs; v1 = v1 * rs;
                *(u32x4*)(rowp + bj * HALF) = pack8(v0, v1); } } }
}

struct EpiInProj { static constexpr bool PERM = true;
    bf16_t *XA, *GGA, *SA, *SB, *CQ, *CKV, *KRP;
    __device__ __forceinline__ void operator()(const Acc& acc, const Unit& u, int wr, int wc, int fr, int fq) const {
        const int pn = u.pn;
        if (pn < 16) store_tile_bf16<0>(acc, XA, DM, pn * 256, 256, u.pm, wr, wc, fr, fq, nullptr);
        else if (pn < 32) store_tile_bf16<1>(acc, GGA, DM, (pn - 16) * 256, 256, u.pm, wr, wc, fr, fq, nullptr);
        else if (pn < 48) store_tile_bf16<2>(acc, SA, DM, (pn - 32) * 256, 256, u.pm, wr, wc, fr, fq, nullptr);
        else if (pn < 64) store_tile_bf16<2>(acc, SB, DM, (pn - 48) * 256, 256, u.pm, wr, wc, fr, fq, nullptr);
        else if (pn < 68) store_tile_bf16<0>(acc, CQ, 1024, (pn - 64) * 256, 256, u.pm, wr, wc, fr, fq, nullptr);
        else if (pn < 70) store_tile_bf16<0>(acc, CKV, 512, (pn - 68) * 256, 256, u.pm, wr, wc, fr, fq, nullptr);
        else store_tile_bf16<0>(acc, KRP, 64, 0, 64, u.pm, wr, wc, fr, fq, nullptr);
    }
};
struct EpiSplit { static constexpr bool PERM = true;
    bf16_t *D0, *D1; int split, ldc; const float* rowscale;
    __device__ __forceinline__ void operator()(const Acc& acc, const Unit& u, int wr, int wc, int fr, int fq) const {
        if (u.pn < split) store_tile_bf16<0>(acc, D0, ldc, u.pn * 256, 256, u.pm, wr, wc, fr, fq, rowscale);
        else store_tile_bf16<0>(acc, D1, ldc, (u.pn - split) * 256, 256, u.pm, wr, wc, fr, fq, rowscale);
    }
};
struct EpiQ { static constexpr bool PERM = true;
    bf16_t *QN, *QR; const float* invq; const float* cs;
    __device__ __forceinline__ void operator()(const Acc& acc, const Unit& u, int wr, int wc, int fr, int fq) const {
        if (u.pn < 16) { store_tile_bf16<0>(acc, QN, DM, u.pn * 256, 256, u.pm, wr, wc, fr, fq, invq); return; }
        const int row0 = u.pm * BM + wr * 64 + fr, cl = wc * 32 + 8 * fq, colt = (u.pn - 16) * 256;
#pragma unroll
        for (int ai = 0; ai < 2; ++ai)
#pragma unroll
            for (int m = 0; m < 4; ++m) { const int row = row0 + ai * HALF + m * 16; const float rs = invq[row];
#pragma unroll
                for (int bj = 0; bj < 2; ++bj) { const int c = colt + bj * HALF + cl;
                    const int j0 = (c & 63) >> 1; const f32x4* cp = (const f32x4*)(cs + ((size_t)row * 32 + j0) * 2);
                    const f32x4 c0 = cp[0], c1 = cp[1];
                    f32x4 v0 = acc[ai][bj][m][0] * rs, v1 = acc[ai][bj][m][1] * rs, o0, o1;
                    o0[0] = v0[0] * c0[0] - v0[1] * c0[1]; o0[1] = v0[1] * c0[0] + v0[0] * c0[1];
                    o0[2] = v0[2] * c0[2] - v0[3] * c0[3]; o0[3] = v0[3] * c0[2] + v0[2] * c0[3];
                    o1[0] = v1[0] * c1[0] - v1[1] * c1[1]; o1[1] = v1[1] * c1[0] + v1[0] * c1[1];
                    o1[2] = v1[2] * c1[2] - v1[3] * c1[3]; o1[3] = v1[3] * c1[2] + v1[2] * c1[3];
                    *(u32x4*)(QR + (size_t)row * 2048 + c) = pack8(o0, o1); } }
    }
};
struct EpiGates { static constexpr bool PERM = true;
    const bf16_t* XC; unsigned char* ws; unsigned char* dob; const float* tab;
    __device__ __forceinline__ void operator()(const Acc& acc, const Unit& u, int wr, int wc, int fr, int fq) const {
        const int dir = u.pn >> 5, chb = ((u.pn >> 1) & 15) * 256 + (u.pn & 1) * 128 + wc * 32 + 8 * fq;
        const int row0 = u.pm * BM + wr * 64 + fr;
        const float* bap = tab + (2 + 2 * dir) * DM; const float* bxp = tab + (3 + 2 * dir) * DM;
        const __amdgpu_buffer_rsrc_t rX = __builtin_amdgcn_make_buffer_rsrc((void*)XC, 0, -1, 0x00020000);
        const __amdgpu_buffer_rsrc_t rR = __builtin_amdgcn_make_buffer_rsrc((void*)(dir ? ws + WS_A0 : dob + DO_D0), 0, -1, 0x00020000);
        const __amdgpu_buffer_rsrc_t rB = __builtin_amdgcn_make_buffer_rsrc((void*)(dir ? ws + WS_A5 : dob + DO_D1), 0, -1, 0x00020000);
        const unsigned vo = (unsigned)(row0 * DM + chb) * 2u;
#pragma unroll
        for (int n = 0; n < 2; ++n) { const int ch0 = chb + 4 * n;
            const f32x4 bav = *(const f32x4*)(bap + ch0), bxv = *(const f32x4*)(bxp + ch0);
#pragma unroll
            for (int ai = 0; ai < 2; ++ai)
#pragma unroll
                for (int m = 0; m < 4; ++m) {
                    const unsigned so = (unsigned)((ai * HALF + m * 16) * DM * 2 + n * 8);
                    const u32x2 xw = __builtin_bit_cast(u32x2, __builtin_amdgcn_raw_buffer_load_b64(rX, vo, so, 0));
                    const f32x4 xv = {bf_lo(xw.x), bf_hi(xw.x), bf_lo(xw.y), bf_hi(xw.y)};
                    const f32x4 za = acc[ai][0][m][n] + bav, zx = acc[ai][1][m][n] + bxv;
                    f32x4 rr, bb;
#pragma unroll
                    for (int i = 0; i < 4; ++i) { rr[i] = sigm(za[i]); bb[i] = sigm(zx[i]) * xv[i]; }
                    u32x2 rw, bw; rw.x = cvt_pk_bf16(rr[0], rr[1]); rw.y = cvt_pk_bf16(rr[2], rr[3]); bw.x = cvt_pk_bf16(bb[0], bb[1]); bw.y = cvt_pk_bf16(bb[2], bb[3]);
                    __builtin_amdgcn_raw_buffer_store_b64(rw, rR, vo, so, 0); __builtin_amdgcn_raw_buffer_store_b64(bw, rB, vo, so, 0);
                    asm volatile("" ::: "memory"); } }
    }
};
template <bool ADD> struct EpiGateMul { static constexpr bool PERM = true;
    const bf16_t* G; bf16_t* T;
    __device__ __forceinline__ void operator()(const Acc& acc, const Unit& u, int wr, int wc, int fr, int fq) const {
        const int row0 = u.pm * BM + wr * 64 + fr, col0 = u.pn * 256 + wc * 32 + 8 * fq;
#pragma unroll
        for (int ai = 0; ai < 2; ++ai)
#pragma unroll
            for (int m = 0; m < 4; ++m) { const size_t ro = (size_t)(row0 + ai * HALF + m * 16) * DM + col0;
#pragma unroll
                for (int bj = 0; bj < 2; ++bj) { const u32x4 gw = *(const u32x4*)(G + ro + bj * HALF);
                    f32x4 g0 = {bf_lo(gw.x), bf_hi(gw.x), bf_lo(gw.y), bf_hi(gw.y)}, g1 = {bf_lo(gw.z), bf_hi(gw.z), bf_lo(gw.w), bf_hi(gw.w)};
                    f32x4 v0 = acc[ai][bj][m][0] * g0, v1 = acc[ai][bj][m][1] * g1;
                    if (ADD) { const u32x4 tw = *(const u32x4*)(T + ro + bj * HALF);
                        v0 += (f32x4){bf_lo(tw.x), bf_hi(tw.x), bf_lo(tw.y), bf_hi(tw.y)}; v1 += (f32x4){bf_lo(tw.z), bf_hi(tw.z), bf_lo(tw.w), bf_hi(tw.w)}; }
                    *(u32x4*)(T + ro + bj * HALF) = pack8(v0, v1); } }
    }
};
template <bool BASE_F32, bool SQ> struct EpiResidBf { static constexpr bool PERM = true;
    const float* xin; bf16_t* XS; float* part;
    __device__ __forceinline__ void operator()(const Acc& acc, const Unit& u, int wr, int wc, int fr, int fq) const {
        const int row0 = u.pm * BM + wr * 64 + fr, col0 = u.pn * 256 + wc * 32 + 8 * fq;
#pragma unroll
        for (int ai = 0; ai < 2; ++ai)
#pragma unroll
            for (int m = 0; m < 4; ++m) { const int row = row0 + ai * HALF + m * 16; const size_t ro = (size_t)row * DM + col0; float sq = 0.f;
#pragma unroll
                for (int bj = 0; bj < 2; ++bj) { f32x4 b0, b1;
                    if (BASE_F32) { b0 = *(const f32x4*)(xin + ro + bj * HALF); b1 = *(const f32x4*)(xin + ro + bj * HALF + 4); }
                    else { const u32x4 w = *(const u32x4*)(XS + ro + bj * HALF); b0 = (f32x4){bf_lo(w.x), bf_hi(w.x), bf_lo(w.y), bf_hi(w.y)}; b1 = (f32x4){bf_lo(w.z), bf_hi(w.z), bf_lo(w.w), bf_hi(w.w)}; }
                    const f32x4 v0 = b0 + acc[ai][bj][m][0], v1 = b1 + acc[ai][bj][m][1];
                    const u32x4 pw = pack8(v0, v1);
                    if (SQ) { const f32x4 r0 = {bf_lo(pw.x), bf_hi(pw.x), bf_lo(pw.y), bf_hi(pw.y)}, r1 = {bf_lo(pw.z), bf_hi(pw.z), bf_lo(pw.w), bf_hi(pw.w)};
                        sq += (r0[0] * r0[0] + r0[1] * r0[1]) + (r0[2] * r0[2] + r0[3] * r0[3]) + (r1[0] * r1[0] + r1[1] * r1[1]) + (r1[2] * r1[2] + r1[3] * r1[3]); }
                    *(u32x4*)(XS + ro + bj * HALF) = pw; }
                if (SQ) { sq += __shfl_xor(sq, 16); sq += __shfl_xor(sq, 32); if (fq == 0) part[(size_t)row * 64 + u.pn * 4 + wc] = sq; } }
    }
};
struct EpiSwiglu { static constexpr bool PERM = true;
    bf16_t* ACT; const float* rowscale;
    __device__ __forceinline__ void operator()(const Acc& acc, const Unit& u, int wr, int wc, int fr, int fq) const {
        const int row0 = u.pm * BM + wr * 64 + fr, col0 = u.pn * 128 + wc * 32 + 8 * fq;
#pragma unroll
        for (int ai = 0; ai < 2; ++ai)
#pragma unroll
            for (int m = 0; m < 4; ++m) { f32x4 v0, v1; const int row = row0 + ai * HALF + m * 16; const float rs = rowscale[row];
#pragma unroll
                for (int i = 0; i < 4; ++i) { v0[i] = silu(acc[ai][0][m][0][i] * rs) * (acc[ai][1][m][0][i] * rs); v1[i] = silu(acc[ai][0][m][1][i] * rs) * (acc[ai][1][m][1][i] * rs); }
                *(u32x4*)(ACT + (size_t)row * DFF + col0) = pack8(v0, v1); }
    }
};

template <class Epi>
__device__ __forceinline__ void gemm_phase(LAS unsigned char* lds, const Gemm g, const StaticOrder& S, const Epi& E, int wave_) {
    const int tid = fresh_tid(wave_), wid = __builtin_amdgcn_readfirstlane(tid >> 6), lane = tid & 63, wr = wid >> 2, wc = wid & 3, fr = lane & 15, fq = lane >> 4;
    const int K = g.K, nt = K / BK;
    unsigned voffA[2], voffB[2];
#pragma unroll
    for (int i = 0; i < 2; ++i) { int R, C; stage_rc(tid * 16 + i * 8192, R, C); const int Rb = Epi::PERM ? ((R & ~31) + perm32(R & 31)) : R;
        voffA[i] = (unsigned)(R * g.lda + C) * 2u; voffB[i] = (unsigned)(Rb * g.ldb + C) * 2u; }
    const unsigned kstep = (unsigned)(BK * 2);
    const unsigned hstepA = (unsigned)HALF * (unsigned)g.lda * 2u, hstepB = (unsigned)HALF * (unsigned)g.ldb * 2u;
    const unsigned ldsw = (unsigned)wid * 1024u;
    const int aoff = lds_byte(wr * 64 + fr, fq * 8), boff = lds_byte(wc * 32 + fr, fq * 8);
    const __amdgpu_buffer_rsrc_t rA = __builtin_amdgcn_make_buffer_rsrc((void*)g.A, 0, -1, 0x00020000), rB = __builtin_amdgcn_make_buffer_rsrc((void*)g.Bt, 0, -1, 0x00020000);
#define PG8_UA(u) ((unsigned)(u).pm * 2u * hstepA + (unsigned)(((u).pn >> g.a_shift) & g.a_mask) * (unsigned)K * 2u)
#define PG8_UB(u) ((unsigned)(u).pn * 2u * hstepB)
#define PG8_SA(b, h) (((b) * 2 + (h)) * HTB)
#define PG8_SB(b, h) ((4 + (b) * 2 + (h)) * HTB)
#define PG8_STAGE(bufoff, rsrc, soff, voff) do { _Pragma("unroll") for (int _i = 0; _i < 2; ++_i) \
        __builtin_amdgcn_raw_ptr_buffer_load_lds(rsrc, (LAS void*)(lds + (bufoff) + ldsw + _i * 8192), 16, (voff)[_i], (soff), 0, 0); } while (0)
#define PG8_LDA(dst, b, h) do { _Pragma("unroll") for (int m = 0; m < 4; ++m) _Pragma("unroll") for (int k = 0; k < 2; ++k) dst[m][k] = *(const LAS bf16x8*)(lds + PG8_SA(b, h) + aoff + m * 2048 + k * 1024); } while (0)
#define PG8_LDB(dst, b, h) do { _Pragma("unroll") for (int n = 0; n < 2; ++n) _Pragma("unroll") for (int k = 0; k < 2; ++k) dst[n][k] = *(const LAS bf16x8*)(lds + PG8_SB(b, h) + boff + n * 2048 + k * 1024); } while (0)
#define PG8_MMA(ai, bj, At, Bt) do { __builtin_amdgcn_s_setprio(1); _Pragma("unroll") for (int m = 0; m < 4; ++m) _Pragma("unroll") for (int n = 0; n < 2; ++n) _Pragma("unroll") for (int k = 0; k < 2; ++k) \
        acc[ai][bj][m][n] = __builtin_amdgcn_mfma_f32_16x16x32_bf16(Bt[n][k], At[m][k], acc[ai][bj][m][n], 0, 0, 0); __builtin_amdgcn_s_setprio(0); } while (0)
#define PG8_WAIT_V(n) asm volatile("s_waitcnt vmcnt(" #n ")" ::: "memory")
#define PG8_WAIT_L(n) asm volatile("s_waitcnt lgkmcnt(" #n ")" ::: "memory")
#define PG8_BAR __builtin_amdgcn_s_barrier()
#define PG8_SCHED __builtin_amdgcn_sched_barrier(0)
    Unit cur, nxt; int ui = 0;
    if (!S.next(0, cur)) return;
    f32x4 acc[2][2][4][2];
#pragma unroll
    for (int a = 0; a < 2; ++a)
#pragma unroll
        for (int b = 0; b < 2; ++b)
#pragma unroll
            for (int m = 0; m < 4; ++m)
#pragma unroll
                for (int n = 0; n < 2; ++n) acc[a][b][m][n] = (f32x4){0.f, 0.f, 0.f, 0.f};
    bf16x8 At[4][2], B0[2][2], B1[2][2];
    unsigned cA = PG8_UA(cur), cB = PG8_UB(cur);
    PG8_STAGE(PG8_SB(0, 0), rB, cB, voffB); PG8_STAGE(PG8_SB(0, 1), rB, cB + hstepB, voffB); PG8_STAGE(PG8_SA(0, 0), rA, cA, voffA); PG8_STAGE(PG8_SA(0, 1), rA, cA + hstepA, voffA);
    if (wr == 1) PG8_BAR;
    PG8_WAIT_V(2); PG8_BAR;
    PG8_STAGE(PG8_SB(1, 0), rB, cB + kstep, voffB); PG8_STAGE(PG8_SA(1, 0), rA, cA + kstep, voffA); PG8_STAGE(PG8_SB(1, 1), rB, cB + hstepB + kstep, voffB);
    PG8_WAIT_V(6); PG8_BAR;
    for (;;) {
        const bool has_next = S.next(ui + 1, nxt);
        const unsigned nA = has_next ? PG8_UA(nxt) : cA, nB = has_next ? PG8_UB(nxt) : cB;
        for (int t = 0; t < nt; t += 2) {
            const bool last = (t == nt - 2);
            const unsigned a1 = cA + (unsigned)(t + 1) * kstep;
            const unsigned a2 = last ? nA : cA + (unsigned)(t + 2) * kstep, b2 = last ? nB : cB + (unsigned)(t + 2) * kstep;
            const unsigned a3 = a2 + kstep, b3 = b2 + kstep;
            PG8_LDB(B0, 0, 0); PG8_LDB(B1, 0, 1); PG8_SCHED; PG8_LDA(At, 0, 0); PG8_STAGE(PG8_SA(1, 1), rA, a1 + hstepA, voffA);
            PG8_WAIT_V(8); PG8_WAIT_L(0); PG8_BAR; PG8_MMA(0, 0, At, B0); PG8_MMA(0, 1, At, B1); PG8_BAR; PG8_SCHED;
            PG8_LDA(At, 0, 1); PG8_STAGE(PG8_SB(0, 0), rB, b2, voffB); PG8_STAGE(PG8_SB(0, 1), rB, b2 + hstepB, voffB); PG8_STAGE(PG8_SA(0, 0), rA, a2, voffA);
            PG8_WAIT_V(8); PG8_WAIT_L(0); PG8_BAR; PG8_MMA(1, 0, At, B0); PG8_MMA(1, 1, At, B1); PG8_BAR; PG8_SCHED;
            PG8_LDB(B0, 1, 0); PG8_LDB(B1, 1, 1); PG8_SCHED; PG8_LDA(At, 1, 0); PG8_STAGE(PG8_SA(0, 1), rA, a2 + hstepA, voffA);
            PG8_WAIT_V(8); PG8_WAIT_L(0); PG8_BAR; PG8_MMA(0, 0, At, B0); PG8_MMA(0, 1, At, B1); PG8_BAR; PG8_SCHED;
            PG8_LDA(At, 1, 1); PG8_STAGE(PG8_SB(1, 0), rB, b3, voffB); PG8_STAGE(PG8_SB(1, 1), rB, b3 + hstepB, voffB); PG8_STAGE(PG8_SA(1, 0), rA, a3, voffA);
            PG8_WAIT_V(8); PG8_WAIT_L(0); PG8_BAR; PG8_MMA(1, 0, At, B0); PG8_MMA(1, 1, At, B1); PG8_BAR; PG8_SCHED;
        }
        if (wr == 0) PG8_BAR;
        PG8_SCHED; E(acc, cur, wr, wc, fr, fq); PG8_SCHED;
        if (!has_next) break;
#pragma unroll
        for (int a = 0; a < 2; ++a)
#pragma unroll
            for (int b = 0; b < 2; ++b)
#pragma unroll
                for (int m = 0; m < 4; ++m)
#pragma unroll
                    for (int n = 0; n < 2; ++n) acc[a][b][m][n] = (f32x4){0.f, 0.f, 0.f, 0.f};
        cur = nxt; cA = nA; cB = nB; ++ui;
        if (wr == 1) PG8_BAR;
    }
    PG8_WAIT_V(0);
    PG8_BAR;
#undef PG8_UA
#undef PG8_UB
#undef PG8_SA
#undef PG8_SB
#undef PG8_STAGE
#undef PG8_LDA
#undef PG8_LDB
#undef PG8_MMA
#undef PG8_WAIT_V
#undef PG8_WAIT_L
#undef PG8_BAR
#undef PG8_SCHED
}
}

namespace att {
constexpr int NW = 8, QBLK = 32, KVBLK = 64;
constexpr int SHM_V = KVBLK * 128 * 2;
#define SBAR() __builtin_amdgcn_sched_barrier(0)
__device__ __forceinline__ int crow(int r, int hi) { return (r & 3) + 8 * (r >> 2) + 4 * hi; }
__device__ __forceinline__ unsigned cvtpk(float lo, float hi) { return cvt_pk_bf16(lo, hi); }
__device__ __forceinline__ bf16x8 ldg8(const bf16_t* p) { return *(const GAS bf16x8*)p; }

template <bool FIRST>
__device__ __forceinline__ void partialSM(f32x16& p0, f32x16& p1, float& m_reg, float& alpha, float thr2) {
    float pmax = p0[0];
#pragma unroll
    for (int r = 1; r < 16; ++r) pmax = fmaxf(pmax, p0[r]);
#pragma unroll
    for (int r = 0; r < 16; ++r) pmax = fmaxf(pmax, p1[r]);
    { auto rr = __builtin_amdgcn_permlane32_swap(__float_as_uint(pmax), __float_as_uint(pmax), false, false);
      pmax = fmaxf(__uint_as_float(rr[0]), __uint_as_float(rr[1])); }
    if (!FIRST && __builtin_expect(__all(pmax <= thr2), 1)) { alpha = 1.f; }
    else { const float d = FIRST ? pmax : fmaxf(pmax, 0.f); alpha = FIRST ? 1.f : __builtin_amdgcn_exp2f(-d); m_reg += d;
#pragma unroll
        for (int r = 0; r < 16; ++r) p0[r] -= d;
#pragma unroll
        for (int r = 0; r < 16; ++r) p1[r] -= d; }
#pragma unroll
    for (int r = 0; r < 16; ++r) p0[r] = __builtin_amdgcn_exp2f(p0[r]);
}
__device__ __forceinline__ void finishSM(f32x16& p0, f32x16& p1, float alpha, float& l_reg, bf16x8& pa0, bf16x8& pa1, bf16x8& pa2, bf16x8& pa3) {
#pragma unroll
    for (int r = 0; r < 16; ++r) p1[r] = __builtin_amdgcn_exp2f(p1[r]);
    float ps = 0;
#pragma unroll
    for (int r = 0; r < 16; ++r) ps += p0[r];
#pragma unroll
    for (int r = 0; r < 16; ++r) ps += p1[r];
    { auto rr = __builtin_amdgcn_permlane32_swap(__float_as_uint(ps), __float_as_uint(ps), false, false);
      ps = __uint_as_float(rr[0]) + __uint_as_float(rr[1]); }
    l_reg = l_reg * alpha + ps;
#define PK4(P, BASE, OUT) do { unsigned a0 = cvtpk(P[BASE + 0], P[BASE + 1]), a1 = cvtpk(P[BASE + 2], P[BASE + 3]);   \
    unsigned b0 = cvtpk(P[BASE + 4], P[BASE + 5]), b1 = cvtpk(P[BASE + 6], P[BASE + 7]);                              \
    auto r0 = __builtin_amdgcn_permlane32_swap(a0, b0, false, false); auto r1 = __builtin_amdgcn_permlane32_swap(a1, b1, false, false); \
    u32x4 w = {r0[0], r1[0], r0[1], r1[1]}; OUT = *reinterpret_cast<bf16x8*>(&w); } while (0)
    PK4(p0, 0, pa0); PK4(p0, 8, pa1); PK4(p1, 0, pa2); PK4(p1, 8, pa3);
#undef PK4
}
__device__ __forceinline__ int v_st(int k, int c) { const int kk = (k & ~0xC) | ((k & 4) << 1) | ((k & 8) >> 1); return ((kk >> 3) * 4 + (c >> 5)) * 512 + ((kk & 7) * 32 + (c & 31)) * 2; }
__device__ __forceinline__ int v_rd_base(int lane) { return ((lane & 3) << 3) | (((lane >> 2) & 3) << 6) | (((lane >> 4) & 1) << 5) | (((lane >> 5) & 1) << 8); }
constexpr int v_rd_off(int d0, int ks, int half) { return d0 * 512 + ks * 4096 + half * 2048; }
template <int OFF> __device__ __forceinline__ s16x4 tr_read(int vb) {
    s16x4 r; asm volatile("ds_read_b64_tr_b16 %0, %1 offset:%2" : "=&v"(r) : "v"(vb), "i"(OFF) : "memory"); return r;
}
template <int D0> __device__ __forceinline__ void pv_one(f32x16& od, int vb, bf16x8 pa0, bf16x8 pa1, bf16x8 pa2, bf16x8 pa3) {
    const s16x4 l0 = tr_read<v_rd_off(D0, 0, 0)>(vb), h0 = tr_read<v_rd_off(D0, 0, 1)>(vb), l1 = tr_read<v_rd_off(D0, 1, 0)>(vb), h1 = tr_read<v_rd_off(D0, 1, 1)>(vb);
    const s16x4 l2 = tr_read<v_rd_off(D0, 2, 0)>(vb), h2 = tr_read<v_rd_off(D0, 2, 1)>(vb), l3 = tr_read<v_rd_off(D0, 3, 0)>(vb), h3 = tr_read<v_rd_off(D0, 3, 1)>(vb);
    asm volatile("s_waitcnt lgkmcnt(0)" ::: "memory"); SBAR();
#define PK(L, H) (bf16x8){L[0], L[1], L[2], L[3], H[0], H[1], H[2], H[3]}
    od = __builtin_amdgcn_mfma_f32_32x32x16_bf16(pa0, PK(l0, h0), od, 0, 0, 0);
    od = __builtin_amdgcn_mfma_f32_32x32x16_bf16(pa1, PK(l1, h1), od, 0, 0, 0);
    od = __builtin_amdgcn_mfma_f32_32x32x16_bf16(pa2, PK(l2, h2), od, 0, 0, 0);
    od = __builtin_amdgcn_mfma_f32_32x32x16_bf16(pa3, PK(l3, h3), od, 0, 0, 0);
#undef PK
}
template <int D0> __device__ __forceinline__ void pv_rd(int vb, s16x4& l0, s16x4& h0, s16x4& l1, s16x4& h1, s16x4& l2, s16x4& h2, s16x4& l3, s16x4& h3) {
    l0 = tr_read<v_rd_off(D0, 0, 0)>(vb); h0 = tr_read<v_rd_off(D0, 0, 1)>(vb); l1 = tr_read<v_rd_off(D0, 1, 0)>(vb); h1 = tr_read<v_rd_off(D0, 1, 1)>(vb);
    l2 = tr_read<v_rd_off(D0, 2, 0)>(vb); h2 = tr_read<v_rd_off(D0, 2, 1)>(vb); l3 = tr_read<v_rd_off(D0, 3, 0)>(vb); h3 = tr_read<v_rd_off(D0, 3, 1)>(vb);
}
#define PVPK(L, H) (bf16x8){L[0], L[1], L[2], L[3], H[0], H[1], H[2], H[3]}
#define PVMMA(od, S) do { od = __builtin_amdgcn_mfma_f32_32x32x16_bf16(pa0, PVPK(S##l0, S##h0), od, 0, 0, 0); od = __builtin_amdgcn_mfma_f32_32x32x16_bf16(pa1, PVPK(S##l1, S##h1), od, 0, 0, 0); \
    od = __builtin_amdgcn_mfma_f32_32x32x16_bf16(pa2, PVPK(S##l2, S##h2), od, 0, 0, 0); od = __builtin_amdgcn_mfma_f32_32x32x16_bf16(pa3, PVPK(S##l3, S##h3), od, 0, 0, 0); } while (0)
__device__ __forceinline__ void pv_d0p(f32x16* o, int vb, bf16x8 pa0, bf16x8 pa1, bf16x8 pa2, bf16x8 pa3) {
    s16x4 Al0, Ah0, Al1, Ah1, Al2, Ah2, Al3, Ah3, Bl0, Bh0, Bl1, Bh1, Bl2, Bh2, Bl3, Bh3;
    pv_rd<0>(vb, Al0, Ah0, Al1, Ah1, Al2, Ah2, Al3, Ah3);
    pv_rd<1>(vb, Bl0, Bh0, Bl1, Bh1, Bl2, Bh2, Bl3, Bh3);
    asm volatile("s_waitcnt lgkmcnt(8)" ::: "memory"); SBAR();
    PVMMA(o[0], A); SBAR();
    pv_rd<2>(vb, Al0, Ah0, Al1, Ah1, Al2, Ah2, Al3, Ah3);
    asm volatile("s_waitcnt lgkmcnt(8)" ::: "memory"); SBAR();
    PVMMA(o[1], B); SBAR();
    pv_rd<3>(vb, Bl0, Bh0, Bl1, Bh1, Bl2, Bh2, Bl3, Bh3);
    asm volatile("s_waitcnt lgkmcnt(8)" ::: "memory"); SBAR();
    PVMMA(o[2], A); SBAR();
    asm volatile("s_waitcnt lgkmcnt(0)" ::: "memory"); SBAR();
    PVMMA(o[3], B);
}
#undef PVMMA
#undef PVPK
__device__ __forceinline__ void pv_d0(f32x16* o, int vb, bf16x8 pa0, bf16x8 pa1, bf16x8 pa2, bf16x8 pa3) {
    pv_one<0>(o[0], vb, pa0, pa1, pa2, pa3); pv_one<1>(o[1], vb, pa0, pa1, pa2, pa3); pv_one<2>(o[2], vb, pa0, pa1, pa2, pa3); pv_one<3>(o[3], vb, pa0, pa1, pa2, pa3);
}

template <int NKA_, int NKB_, int NQREG_, int NQLDS_, int LDQA_, int LDQB_, int LDKA_, int LDKB_, int LDV_, int LDO_, int SEQK_>
struct Cfg { static constexpr int NKA = NKA_, NKB = NKB_, NQREG = NQREG_, NQLDS = NQLDS_, LDQA = LDQA_, LDQB = LDQB_, LDKA = LDKA_, LDKB = LDKB_, LDV = LDV_, LDO = LDO_, SEQK = SEQK_; };
typedef __amdgpu_buffer_rsrc_t rsrc_t;
__device__ __forceinline__ rsrc_t mkrsrc(const void* p) { return __builtin_amdgcn_make_buffer_rsrc((void*)p, 0, -1, 0x00020000); }
__device__ __forceinline__ bf16x8 ldgo(rsrc_t r, unsigned voff, unsigned soff) { return __builtin_bit_cast(bf16x8, __builtin_amdgcn_raw_buffer_load_b128(r, voff, soff, 0)); }
template <class CF>
__device__ __forceinline__ void attn_unit(const bf16_t* QA, const bf16_t* QB, const bf16_t* KA, const bf16_t* KB, const bf16_t* Vh, bf16_t* Ob, float thr_raw, char* lds, int wave_) {
    constexpr int NKA = CF::NKA, NKB = CF::NKB, NQREG = CF::NQREG, NQLDS = CF::NQLDS, NKC = NKA + NKB, SHM_K = NKC * 8192;
    const int tid = fresh_tid(wave_), wid = tid >> 6, lane = tid & 63, r32 = lane & 31, hi = lane >> 5;
    char* V_lds = lds; char* K_lds = lds + 2 * SHM_V;
    float* ws = (float*)(lds + 2 * SHM_V + 2 * SHM_K) + wid * 64; float* li_l = ws; float* al_l = ws + 32;
    float m_reg = 0.f, l_reg = 0; f32x16 o[4];
    { float z_ = 0.f; asm volatile("" : "+v"(z_));
#pragma unroll
      for (int d = 0; d < 4; ++d)
#pragma unroll
          for (int r = 0; r < 16; ++r) o[d][r] = z_; } bf16x8 qr[NQREG ? 4 * NQREG : 1];
    const rsrc_t rQA = mkrsrc(QA), rQB = mkrsrc(QB), rKA = mkrsrc(KA), rKB = mkrsrc(KB), rV = mkrsrc(Vh), rO = mkrsrc(Ob);
    const unsigned qoffA = (unsigned)((wid * QBLK + r32) * CF::LDQA + hi * 8) * 2u, qoffB = (unsigned)((wid * QBLK + r32) * CF::LDQB + hi * 8) * 2u;
    char* q_lds = lds + 2 * SHM_V + 2 * SHM_K + 2048 + wid * (NQLDS ? NQLDS * 4096 : 0) + lane * 16;
    __syncthreads();
#pragma unroll
    for (int c = 0; c < NKC; ++c)
#pragma unroll
        for (int d0 = 0; d0 < 4; ++d0) {
            if (c < NQREG) qr[c * 4 + d0] = (c < NKA) ? ldgo(rQA, qoffA, (c * 64 + d0 * 16) * 2) : ldgo(rQB, qoffB, ((c - NKA) * 64 + d0 * 16) * 2);
            else if (c < NQREG + NQLDS) *(bf16x8*)(q_lds + ((c - NQREG) * 4 + d0) * 1024) = (c < NKA) ? ldgo(rQA, qoffA, (c * 64 + d0 * 16) * 2) : ldgo(rQB, qoffB, ((c - NKA) * 64 + d0 * 16) * 2);
        }
    const int ksw = (r32 >> 1) & 7;
    int koff[4];
#pragma unroll
    for (int d0 = 0; d0 < 4; ++d0) koff[d0] = r32 * 128 + (((d0 * 2 + hi) ^ ksw) << 4);
    const int krow = tid >> 3, kp = tid & 7, kst = krow * 128 + ((kp ^ ((krow >> 1) & 7)) << 4);
    const int sr = tid >> 4, sc = (tid & 15) * 8, vst0 = v_st(sr, sc), vst1 = v_st(32 + sr, sc);
    const unsigned kgA = (unsigned)(krow * CF::LDKA + kp * 8) * 2u, kgB = (unsigned)(krow * CF::LDKB + kp * 8) * 2u, vg = (unsigned)(sr * CF::LDV + sc) * 2u;
    const int vb0 = (int)(uintptr_t)V_lds + v_rd_base(lane);
    bf16x8 s_vs0, s_vs1, s_ks[NKC];
#define SLOAD(k0) do { const unsigned vt_ = (unsigned)(k0) * (CF::LDV * 2u), ka_ = (unsigned)(k0) * (CF::LDKA * 2u), kb_ = (unsigned)(k0) * (CF::LDKB * 2u); \
    s_vs0 = ldgo(rV, vg, vt_); s_vs1 = ldgo(rV, vg, vt_ + 32u * CF::LDV * 2u); \
    _Pragma("unroll") for (int c = 0; c < NKC; ++c) s_ks[c] = (c < NKA) ? ldgo(rKA, kgA, ka_ + c * 128) : ldgo(rKB, kgB, kb_ + (c - NKA) * 128); } while (0)
#define SWRITE(b) do { *(bf16x8*)(V_lds + (b) * SHM_V + vst0) = s_vs0; *(bf16x8*)(V_lds + (b) * SHM_V + vst1) = s_vs1; \
    _Pragma("unroll") for (int c = 0; c < NKC; ++c) *(bf16x8*)(K_lds + (b) * SHM_K + c * 8192 + kst) = s_ks[c]; } while (0)
#define SWAIT() asm volatile("s_waitcnt vmcnt(0)" ::: "memory")
#define RESC(a) do { if (__any((a) < 1.f)) { if (hi == 0) al_l[r32] = (a); asm volatile("s_waitcnt lgkmcnt(0)" ::: "memory"); \
    _Pragma("unroll") for (int d = 0; d < 4; ++d) _Pragma("unroll") for (int r = 0; r < 16; ++r) o[d][r] *= al_l[crow(r, hi)]; } } while (0)
#define QKT(P0, P1, KB_) QKT_(P0, P1, KB_, false)
#define QKT_(P0, P1, KB_, ZERO_) do { __builtin_amdgcn_iglp_opt(0); if (ZERO_) { P0 = f32x16{}; P1 = f32x16{}; } else { const float nm_ = -m_reg; _Pragma("unroll") for (int r_ = 0; r_ < 16; ++r_) { P0[r_] = nm_; P1[r_] = nm_; } } const char* kt_ = K_lds + (KB_) * SHM_K; \
    _Pragma("unroll") for (int c = 0; c < NKC; ++c) _Pragma("unroll") for (int d0 = 0; d0 < 4; ++d0) { \
        const bf16x8 b0 = *(const bf16x8*)(kt_ + c * 8192 + koff[d0]); const bf16x8 b1 = *(const bf16x8*)(kt_ + c * 8192 + 4096 + koff[d0]); \
        bf16x8 qf; if (c < NQREG) qf = qr[(c < NQREG ? c : 0) * 4 + d0]; else if (c < NQREG + NQLDS) qf = *(const bf16x8*)(q_lds + ((c - NQREG) * 4 + d0) * 1024); \
        else qf = (c < NKA) ? ldgo(rQA, qoffA, (c * 64 + d0 * 16) * 2) : ldgo(rQB, qoffB, ((c - NKA) * 64 + d0 * 16) * 2); \
        P0 = __builtin_amdgcn_mfma_f32_32x32x16_bf16(b0, qf, P0, 0, 0, 0); P1 = __builtin_amdgcn_mfma_f32_32x32x16_bf16(b1, qf, P1, 0, 0, 0); } } while (0)
    f32x16 pA0, pA1, pB0, pB1; float alA, alB; bf16x8 pa0, pa1, pa2, pa3; constexpr int NT = CF::SEQK / KVBLK;
    SLOAD(0); SWAIT(); SWRITE(0); __syncthreads();
    QKT_(pA0, pA1, 0, true); partialSM<true>(pA0, pA1, m_reg, alA, thr_raw);
    SLOAD(KVBLK);
    SWAIT(); SWRITE(1); __syncthreads();
    for (int j = 1; j + 1 < NT; j += 2) {
        SBAR(); QKT(pB0, pB1, 1);
        finishSM(pA0, pA1, alA, l_reg, pa0, pa1, pa2, pa3); SBAR();
        SLOAD((j + 1) * KVBLK); SBAR();
        pv_d0(o, vb0, pa0, pa1, pa2, pa3); partialSM<false>(pB0, pB1, m_reg, alB, thr_raw);
        __syncthreads(); SWAIT(); SWRITE(0);
        RESC(alB); __syncthreads();
        SBAR(); QKT(pA0, pA1, 0);
        finishSM(pB0, pB1, alB, l_reg, pa0, pa1, pa2, pa3); SBAR();
        SLOAD((j + 2) * KVBLK); SBAR();
        pv_d0(o, vb0 + SHM_V, pa0, pa1, pa2, pa3); partialSM<false>(pA0, pA1, m_reg, alA, thr_raw);
        __syncthreads(); SWAIT(); SWRITE(1);
        RESC(alA); __syncthreads();
    }
    SBAR(); QKT(pB0, pB1, 1);
    finishSM(pA0, pA1, alA, l_reg, pa0, pa1, pa2, pa3); SBAR();
    pv_d0(o, vb0, pa0, pa1, pa2, pa3); partialSM<false>(pB0, pB1, m_reg, alB, thr_raw);
    __syncthreads(); RESC(alB);
    finishSM(pB0, pB1, alB, l_reg, pa0, pa1, pa2, pa3); SBAR();
    pv_d0(o, vb0 + SHM_V, pa0, pa1, pa2, pa3);
    if (hi == 0) li_l[r32] = l_reg; asm volatile("s_waitcnt lgkmcnt(0)" ::: "memory");
    float rli[16];
#pragma unroll
    for (int r = 0; r < 16; ++r) rli[r] = __builtin_amdgcn_rcpf(li_l[crow(r, hi)]);
    const unsigned ob = (unsigned)((wid * QBLK + 4 * hi) * CF::LDO + r32) * 2u;
#pragma unroll
    for (int r = 0; r < 16; ++r) {
#pragma unroll
        for (int d0 = 0; d0 < 4; ++d0) __builtin_amdgcn_raw_buffer_store_b16((short)f2bf(o[d0][r] * rli[r]), rO, ob, (unsigned)((((r & 3) + 8 * (r >> 2)) * CF::LDO + d0 * 32) * 2), 0); }
#undef SLOAD
#undef SWRITE
#undef SWAIT
#undef RESC
#undef QKT
#undef QKT_
}
template <class CF>
__device__ __forceinline__ void attn_unit_dma(const bf16_t* QA, const bf16_t* QB, const bf16_t* KA, const bf16_t* KB, const bf16_t* Vh, bf16_t* Ob, float thr_raw, char* lds, LAS unsigned char* ldsl, int wave_) {
    constexpr int NKA = CF::NKA, NKB = CF::NKB, NQREG = CF::NQREG, NKC = NKA + NKB, SHM_K = NKC * 8192;
    static_assert(CF::NQLDS == 0 && NQREG == NKC, "all Q chunks in registers");
    const int tid = fresh_tid(wave_), wid = tid >> 6, lane = tid & 63, r32 = lane & 31, hi = lane >> 5;
    char* V_lds = lds; char* K_lds = lds + 2 * SHM_V;
    float* ws = (float*)(lds + 2 * SHM_V + 2 * SHM_K) + wid * 64; float* li_l = ws; float* al_l = ws + 32;
    float m_reg = 0.f, l_reg = 0; f32x16 o[4];
    { float z_ = 0.f; asm volatile("" : "+v"(z_));
#pragma unroll
      for (int d = 0; d < 4; ++d)
#pragma unroll
          for (int r = 0; r < 16; ++r) o[d][r] = z_; } bf16x8 qr[4 * NQREG];
    const rsrc_t rQA = mkrsrc(QA), rQB = mkrsrc(QB), rKA = mkrsrc(KA), rKB = mkrsrc(KB), rV = mkrsrc(Vh), rO = mkrsrc(Ob);
    const unsigned qoffA = (unsigned)((wid * QBLK + r32) * CF::LDQA + hi * 8) * 2u, qoffB = (unsigned)((wid * QBLK + r32) * CF::LDQB + hi * 8) * 2u;
    __syncthreads();
    const int kr_ = 8 * wave_ + (lane >> 3), kp_ = (lane & 7) ^ ((kr_ >> 1) & 7);
    const unsigned kdA = (unsigned)(kr_ * CF::LDKA) * 2u + (unsigned)kp_ * 16u, kdB = (unsigned)(kr_ * CF::LDKB) * 2u + (unsigned)kp_ * 16u;
    unsigned vd[2];
    { const int kk = 8 * wave_ + ((lane >> 2) & 7), k = (kk & ~0xC) | ((kk & 4) << 1) | ((kk & 8) >> 1);
#pragma unroll
      for (int i = 0; i < 2; ++i) vd[i] = (unsigned)(k * CF::LDV + (2 * i + (lane >> 5)) * 32 + (lane & 3) * 8) * 2u; }
#define KPIECE(b, k0, c) do { if ((c) < NKA) __builtin_amdgcn_raw_ptr_buffer_load_lds(rKA, (LAS void*)(ldsl + 2 * SHM_V + (b) * SHM_K + (c) * 8192 + wave_ * 1024), 16, kdA, (unsigned)(k0) * (CF::LDKA * 2u) + (c) * 128, 0, 0); \
        else __builtin_amdgcn_raw_ptr_buffer_load_lds(rKB, (LAS void*)(ldsl + 2 * SHM_V + (b) * SHM_K + (c) * 8192 + wave_ * 1024), 16, kdB, (unsigned)(k0) * (CF::LDKB * 2u) + ((c) - NKA) * 128, 0, 0); } while (0)
#define VPIECE(b, k0, i) __builtin_amdgcn_raw_ptr_buffer_load_lds(rV, (LAS void*)(ldsl + (b) * SHM_V + (2 * wave_ + (i)) * 1024), 16, vd[i], (unsigned)(k0) * (CF::LDV * 2u), 0, 0)
#define KDMA(b, k0) do { _Pragma("unroll") for (int c = 0; c < NKC; ++c) KPIECE(b, k0, c); } while (0)
#define VDMA(b, k0) do { _Pragma("unroll") for (int i = 0; i < 2; ++i) VPIECE(b, k0, i); } while (0)
#define BARD() do { asm volatile("s_waitcnt vmcnt(0) lgkmcnt(0)" ::: "memory"); __builtin_amdgcn_s_barrier(); asm volatile("" ::: "memory"); } while (0)
    KDMA(0, 0); VDMA(0, 0); KDMA(1, KVBLK);
#pragma unroll
    for (int c = 0; c < NKC; ++c)
#pragma unroll
        for (int d0 = 0; d0 < 4; ++d0) qr[c * 4 + d0] = (c < NKA) ? ldgo(rQA, qoffA, (c * 64 + d0 * 16) * 2) : ldgo(rQB, qoffB, ((c - NKA) * 64 + d0 * 16) * 2);
    const int ksw = (r32 >> 1) & 7;
    int koff[4];
#pragma unroll
    for (int d0 = 0; d0 < 4; ++d0) koff[d0] = r32 * 128 + (((d0 * 2 + hi) ^ ksw) << 4);
    const int vb0 = (int)(uintptr_t)V_lds + v_rd_base(lane);
#define RESC(a) do { if (__any((a) < 1.f)) { if (hi == 0) al_l[r32] = (a); asm volatile("s_waitcnt lgkmcnt(0)" ::: "memory"); \
    _Pragma("unroll") for (int d = 0; d < 4; ++d) _Pragma("unroll") for (int r = 0; r < 16; ++r) o[d][r] *= al_l[crow(r, hi)]; } } while (0)
#define QKT_(P0, P1, KB_, ZERO_, DOK_, KD_, KK0_, DOV_, VD_, VK0_) do { __builtin_amdgcn_iglp_opt(0); if (ZERO_) { P0 = f32x16{}; P1 = f32x16{}; } else { const float nm_ = -m_reg; _Pragma("unroll") for (int r_ = 0; r_ < 16; ++r_) { P0[r_] = nm_; P1[r_] = nm_; } } const char* kt_ = K_lds + (KB_) * SHM_K; \
    _Pragma("unroll") for (int c = 0; c < NKC; ++c) _Pragma("unroll") for (int d0 = 0; d0 < 4; ++d0) { \
        const bf16x8 b0 = *(const bf16x8*)(kt_ + c * 8192 + koff[d0]); const bf16x8 b1 = *(const bf16x8*)(kt_ + c * 8192 + 4096 + koff[d0]); \
        const bf16x8 qf = qr[c * 4 + d0]; \
        P0 = __builtin_amdgcn_mfma_f32_32x32x16_bf16(b0, qf, P0, 0, 0, 0); P1 = __builtin_amdgcn_mfma_f32_32x32x16_bf16(b1, qf, P1, 0, 0, 0); \
        { const int t_ = 4 * c + d0; if (DOK_) { if (t_ == 1) KPIECE(KD_, KK0_, 0); if (t_ == 3) KPIECE(KD_, KK0_, 1); if (t_ == 5) KPIECE(KD_, KK0_, 2); } \
          if (DOV_) { if (t_ == 7) VPIECE(VD_, VK0_, 0); if (t_ == 9) VPIECE(VD_, VK0_, 1); } } } } while (0)
    f32x16 pA0, pA1, pB0, pB1; float alA, alB; bf16x8 pa0, pa1, pa2, pa3; constexpr int NT = CF::SEQK / KVBLK;
    static_assert(NT % 2 == 0 && NT >= 4, "tile count");
    BARD();
    QKT_(pA0, pA1, 0, true, false, 0, 0, false, 0, 0); partialSM<true>(pA0, pA1, m_reg, alA, thr_raw);
    for (int j = 0; j + 2 < NT; j += 2) {
        BARD(); SBAR();
        QKT_(pB0, pB1, 1, false, true, 0, (j + 2) * KVBLK, true, 1, (j + 1) * KVBLK);
        finishSM(pA0, pA1, alA, l_reg, pa0, pa1, pa2, pa3); SBAR();
        pv_d0p(o, vb0, pa0, pa1, pa2, pa3); partialSM<false>(pB0, pB1, m_reg, alB, thr_raw);
        RESC(alB);
        BARD(); SBAR();
        QKT_(pA0, pA1, 0, false, true, 1, (j + 3) * KVBLK, true, 0, (j + 2) * KVBLK);
        finishSM(pB0, pB1, alB, l_reg, pa0, pa1, pa2, pa3); SBAR();
        pv_d0p(o, vb0 + SHM_V, pa0, pa1, pa2, pa3); partialSM<false>(pA0, pA1, m_reg, alA, thr_raw);
        RESC(alA);
    }
    BARD(); SBAR();
    QKT_(pB0, pB1, 1, false, false, 0, 0, true, 1, (NT - 1) * KVBLK);
    finishSM(pA0, pA1, alA, l_reg, pa0, pa1, pa2, pa3); SBAR();
    pv_d0p(o, vb0, pa0, pa1, pa2, pa3); partialSM<false>(pB0, pB1, m_reg, alB, thr_raw);
    RESC(alB);
    BARD(); SBAR();
    finishSM(pB0, pB1, alB, l_reg, pa0, pa1, pa2, pa3); SBAR();
    pv_d0p(o, vb0 + SHM_V, pa0, pa1, pa2, pa3);
    if (hi == 0) li_l[r32] = l_reg; asm volatile("s_waitcnt lgkmcnt(0)" ::: "memory");
    float rli[16];
#pragma unroll
    for (int r = 0; r < 16; ++r) rli[r] = __builtin_amdgcn_rcpf(li_l[crow(r, hi)]);
    const unsigned ob = (unsigned)((wid * QBLK + 4 * hi) * CF::LDO + r32) * 2u;
#pragma unroll
    for (int r = 0; r < 16; ++r) {
#pragma unroll
        for (int d0 = 0; d0 < 4; ++d0) __builtin_amdgcn_raw_buffer_store_b16((short)f2bf(o[d0][r] * rli[r]), rO, ob, (unsigned)((((r & 3) + 8 * (r >> 2)) * CF::LDO + d0 * 32) * 2), 0); }
#undef KPIECE
#undef VPIECE
#undef KDMA
#undef VDMA
#undef BARD
#undef RESC
#undef QKT_
}
}

#define XB_TMO      128
#define XB_XCNT(j)  (256  + 64 * (j))
#define XB_XSUB(j)  (1280 + 64 * (j))
#define XB_XGEN(j)  (2304 + 64 * (j))
#define XB_TOP      3328
#define XB_TOPGEN   3392
#define XCD_BAR_WORDS 3456
#define XB_SPIN_CAP (1u << 20)
__device__ __forceinline__ unsigned xb_ld(unsigned* p)              { return __hip_atomic_load(p, __ATOMIC_RELAXED, __HIP_MEMORY_SCOPE_AGENT); }
__device__ __forceinline__ unsigned xb_add(unsigned* p, unsigned v) { return __hip_atomic_fetch_add(p, v, __ATOMIC_RELAXED, __HIP_MEMORY_SCOPE_AGENT); }
__device__ __forceinline__ unsigned xb_xcc_id() { return (unsigned)__builtin_amdgcn_s_getreg((3 << 11) | 20) & 0xFu; }
#define XB_SPIN(cond, bar) do { unsigned _sp = 0; while (cond) { __builtin_amdgcn_s_sleep(1); \
    if ((++_sp & 255u) == 0u) { if (xb_ld(&(bar)[XB_TMO])) break; if (_sp > XB_SPIN_CAP) { atomicAdd(&(bar)[XB_TMO], 1u); break; } } } } while (0)
struct XcdBarrier { unsigned* bar; unsigned x; volatile LAS unsigned* st; };
__device__ __forceinline__ XcdBarrier xcd_barrier_post(unsigned* bar, volatile LAS unsigned* st, int wave_) {
    XcdBarrier b; b.bar = bar; b.x = xb_xcc_id(); b.st = st;
    if (wave_ == 0 && lane_id() == 0) (void)xb_add(&bar[XB_XCNT(b.x)], 1u);
    return b;
}
__device__ __forceinline__ void xcd_barrier_complete(unsigned* bar, unsigned x, unsigned& nloc, unsigned& nx) {
    const unsigned G = gridDim.x * gridDim.y * gridDim.z;
    unsigned sum, cnt, mine, sp = 0u;
    for (;;) {
        sum = 0u; cnt = 0u; mine = 0u;
#pragma unroll
        for (unsigned j = 0; j < 16; ++j) { const unsigned c = xb_ld(&bar[XB_XCNT(j)]); sum += c; cnt += (c > 0u) ? 1u : 0u; mine = (j == x) ? c : mine; }
        if (sum == G) break;
        __builtin_amdgcn_s_sleep(1);
        if ((++sp & 255u) == 0u) { if (xb_ld(&bar[XB_TMO])) break; if (sp > XB_SPIN_CAP) { atomicAdd(&bar[XB_TMO], 1u); break; } }
    }
    nloc = mine > 0u ? mine : 1u; nx = cnt > 0u ? cnt : 1u;
}
__device__ __forceinline__ void xcd_barrier(const XcdBarrier& b, int wave_) {
    asm volatile("s_waitcnt vmcnt(0)" ::: "memory");
    __syncthreads();
    if (wave_ == 0 && lane_id() == 0) {
        unsigned* bar = b.bar;
        __builtin_amdgcn_s_waitcnt(0);
        unsigned nloc = b.st[0], nx = b.st[1];
        if (nloc == 0u) { xcd_barrier_complete(bar, b.x, nloc, nx); b.st[0] = nloc; b.st[1] = nx; }
        const unsigned old = xb_add(&bar[XB_XSUB(b.x)], 1u);
        const unsigned gen = old / nloc;
        if (old + 1u == (gen + 1u) * nloc) {
            __builtin_amdgcn_fence(__ATOMIC_RELEASE, "agent");
            asm volatile("s_waitcnt vmcnt(0)" ::: "memory");
            const unsigned og = xb_add(&bar[XB_TOP], 1u);
            const unsigned tg = og / nx;
            if (og + 1u == (tg + 1u) * nx) xb_add(&bar[XB_TOPGEN], 1u);
            else XB_SPIN(xb_ld(&bar[XB_TOPGEN]) == tg, bar);
            __builtin_amdgcn_fence(__ATOMIC_ACQUIRE, "agent");
            xb_add(&bar[XB_XGEN(b.x)], 1u);
            asm volatile("s_waitcnt vmcnt(0)" ::: "memory");
        } else {
            XB_SPIN(xb_ld(&bar[XB_XGEN(b.x)]) == gen, bar);
            __builtin_amdgcn_fence(__ATOMIC_ACQUIRE, "agent");
            asm volatile("s_waitcnt vmcnt(0)" ::: "memory");
        }
    }
    __syncthreads();
}

struct Args { const void* in[34]; float* out; unsigned char* ws; int ph_lo, ph_hi; };

struct Frame {
    LAS unsigned char* lds; int wave, vcu, G;
};
#define FTID (F.wave * 64 + lane_id())
#define FLANE lane_id()

enum { MAP_ID = 0, MAP_IN, MAP_UQ, MAP_UKV, MAP_MKV, MAP_FG, MAP_FU };
__device__ __forceinline__ int dest_row(int map, int c) {
    switch (map) {
    case MAP_IN:  return c < 8192 ? c : c < 9216 ? 16384 + (c - 8192) : c < 9728 ? 17408 + (c - 9216) : c < 9792 ? 17920 + (c - 9728) : c < 13888 ? 8192 + (c - 9792) : 12288 + (c - 13888);
    case MAP_UQ:  { const int head = c / 192, d = c - head * 192; return d < 128 ? head * 128 + d : 4096 + head * 64 + 2 * ((d - 128) & 31) + ((d - 128) >> 5); }
    case MAP_UKV: { const int head = c >> 8, d = c & 255; return d < 128 ? head * 128 + d : 4096 + head * 128 + (d - 128); }
    case MAP_MKV: { const int head = c >> 9, e = c & 511; return e < 256 ? head * 256 + e : 1024 + head * 256 + (e - 256); }
    case MAP_FG:  return (c >> 7) * 256 + (c & 127);
    case MAP_FU:  return (c >> 7) * 256 + 128 + (c & 127);
    default:      return c;
    }
}
__device__ __forceinline__ void cvt_item64(const float* src, int ld, int K, int nblk, bf16_t* dst, int map, int row_add, const float* kscale, LAS unsigned* tile, int item, int lane) {
    const int kb = item / nblk, nb = item - kb * nblk, k0 = 64 * kb, c0 = 64 * nb, q = lane & 15, kr = lane >> 4;
    const GAS float* sp = (const GAS float*)src + (size_t)(k0 + 2 * kr) * ld + c0 + 4 * q;
    f32x4 v[8][2];
#pragma unroll
    for (int m = 0; m < 8; ++m)
#pragma unroll
        for (int e = 0; e < 2; ++e) v[m][e] = __builtin_nontemporal_load((const GAS f32x4*)(sp + (size_t)(8 * m + e) * ld));
    if (kscale) {
#pragma unroll
        for (int m = 0; m < 8; ++m)
#pragma unroll
            for (int e = 0; e < 2; ++e) v[m][e] = v[m][e] * kscale[k0 + 8 * m + 2 * kr + e];
    }
#pragma unroll
    for (int m = 0; m < 8; ++m)
#pragma unroll
        for (int i = 0; i < 4; ++i) tile[(4 * q + i) * 33 + 4 * m + kr] = cvt_pk_bf16(v[m][0][i], v[m][1][i]);
    LDS_WAIT(); asm volatile("" ::: "memory");
    const int c = lane & 7;
    const int dbase = dest_row(map, c0) + row_add; const bool rope = (map == MAP_UQ) && (c0 % 192 == 128);
#pragma unroll
    for (int j = 0; j < 8; ++j) { const int n = (lane >> 3) + 8 * j; const LAS unsigned* tp = tile + n * 33 + 4 * c;
        u32x4 o; o.x = tp[0]; o.y = tp[1]; o.z = tp[2]; o.w = tp[3];
        *(GAS u32x4*)(dst + (size_t)(dbase + (rope ? 2 * (n & 31) + (n >> 5) : n)) * K + k0 + 8 * c) = o; }
    LDS_WAIT(); asm volatile("" ::: "memory");
}

template <bool OUTF>
__device__ __forceinline__ void rms_rows(const Frame& F, const float* src, const float* g, void* dst, int rows) {
    const int gw = F.vcu * NWAVES + F.wave, NGW = F.G * NWAVES, lane = FLANE;
    int m = gw; if (m >= rows) return;
    f32x4 gv[16], v[16], vn[16];
#pragma unroll
    for (int j = 0; j < 16; ++j) gv[j] = ((const GAS f32x4*)g)[64 * j + lane];
#pragma unroll
    for (int j = 0; j < 16; ++j) v[j] = ((const GAS f32x4*)(src + (size_t)m * DM))[64 * j + lane];
    for (;;) {
        const int mn = m + NGW; const bool hn = mn < rows;
        if (hn) {
#pragma unroll
            for (int j = 0; j < 16; ++j) vn[j] = ((const GAS f32x4*)(src + (size_t)mn * DM))[64 * j + lane]; }
        asm volatile("" ::: "memory");
        float s = 0.f;
#pragma unroll
        for (int j = 0; j < 16; ++j) s += (v[j].x * v[j].x + v[j].y * v[j].y) + (v[j].z * v[j].z + v[j].w * v[j].w);
        const float inv = __builtin_amdgcn_rsqf(wave_sum(s) * (1.f / DM) + EPS);
        if constexpr (OUTF) { GAS f32x4* o = (GAS f32x4*)((float*)dst + (size_t)m * DM) + lane;
#pragma unroll
            for (int j = 0; j < 16; ++j) o[64 * j] = v[j] * inv * gv[j];
        } else { GAS u32x2* o = (GAS u32x2*)((bf16_t*)dst + (size_t)m * DM) + lane;
#pragma unroll
            for (int j = 0; j < 16; ++j) { const f32x4 t = v[j] * inv * gv[j]; u32x2 w; w.x = cvt_pk_bf16(t.x, t.y); w.y = cvt_pk_bf16(t.z, t.w); o[64 * j] = w; } }
        if (!hn) break;
#pragma unroll
        for (int j = 0; j < 16; ++j) v[j] = vn[j];
        m = mn;
    }
}

__device__ __forceinline__ void rms_rows_bf(const Frame& F, const bf16_t* src, const float* g, float* dst, int rows) {
    const int gw = F.vcu * NWAVES + F.wave, NGW = F.G * NWAVES, lane = FLANE;
    int m = gw; if (m >= rows) return;
    f32x4 gv[16]; u32x4 v[8], vn[8];
#pragma unroll
    for (int j = 0; j < 8; ++j) { gv[2 * j] = ((const GAS f32x4*)g)[2 * (64 * j + lane)]; gv[2 * j + 1] = ((const GAS f32x4*)g)[2 * (64 * j + lane) + 1]; }
#pragma unroll
    for (int j = 0; j < 8; ++j) v[j] = ((const GAS u32x4*)(src + (size_t)m * DM))[64 * j + lane];
    for (;;) {
        const int mn = m + NGW; const bool hn = mn < rows;
        if (hn) {
#pragma unroll
            for (int j = 0; j < 8; ++j) vn[j] = ((const GAS u32x4*)(src + (size_t)mn * DM))[64 * j + lane]; }
        asm volatile("" ::: "memory");
        float s = 0.f; f32x4 f[16];
#pragma unroll
        for (int j = 0; j < 8; ++j) { f[2 * j] = (f32x4){bf_lo(v[j].x), bf_hi(v[j].x), bf_lo(v[j].y), bf_hi(v[j].y)}; f[2 * j + 1] = (f32x4){bf_lo(v[j].z), bf_hi(v[j].z), bf_lo(v[j].w), bf_hi(v[j].w)}; }
#pragma unroll
        for (int j = 0; j < 16; ++j) s += (f[j].x * f[j].x + f[j].y * f[j].y) + (f[j].z * f[j].z + f[j].w * f[j].w);
        const float inv = __builtin_amdgcn_rsqf(wave_sum(s) * (1.f / DM) + EPS);
        GAS f32x4* o = (GAS f32x4*)(dst + (size_t)m * DM);
#pragma unroll
        for (int j = 0; j < 8; ++j) { __builtin_nontemporal_store(f[2 * j] * inv * gv[2 * j], &o[2 * (64 * j + lane)]); __builtin_nontemporal_store(f[2 * j + 1] * inv * gv[2 * j + 1], &o[2 * (64 * j + lane) + 1]); }
        if (!hn) break;
#pragma unroll
        for (int j = 0; j < 8; ++j) v[j] = vn[j];
        m = mn;
    }
}
__device__ __forceinline__ void inv_rows(const Frame& F, const float* part, float* inv, float cmul) {
    for (int row = blockIdx.x * (NWAVES * 64) + FTID; row < M; row += F.G * NWAVES * 64) { const GAS f32x4* p = (const GAS f32x4*)(part + (size_t)row * 64); float s = 0.f;
#pragma unroll
        for (int j = 0; j < 16; ++j) { const f32x4 t = p[j]; s += (t.x + t.y) + (t.z + t.w); }
        inv[row] = cmul * __builtin_amdgcn_rsqf(s * (1.f / DM) + EPS); }
}

constexpr int NDEF = 3 * 11008 + 3 * 4096 + 2 * 1024;
__device__ __forceinline__ void cvt_deferred(const Args& a, unsigned char* ws, int it, LAS unsigned* tile, int lane) {
    if (it < 11008)      cvt_item64((const float*)a.in[30], DFF, DM, DFF / 64, (bf16_t*)(ws + WS_WGU), MAP_FG, 0, (const float*)a.in[29], tile, it, lane);
    else if (it < 22016) cvt_item64((const float*)a.in[31], DFF, DM, DFF / 64, (bf16_t*)(ws + WS_WGU), MAP_FU, 0, (const float*)a.in[29], tile, it - 11008, lane);
    else if (it < 33024) cvt_item64((const float*)a.in[32], DM, DFF, DM / 64, (bf16_t*)(ws + WS_WD), MAP_ID, 0, nullptr, tile, it - 22016, lane);
    else if (it < 37120) cvt_item64((const float*)a.in[21], DM, DM, DM / 64, (bf16_t*)(ws + WS_WPL), MAP_ID, 0, nullptr, tile, it - 33024, lane);
    else if (it < 41216) cvt_item64((const float*)a.in[22], DM, DM, DM / 64, (bf16_t*)(ws + WS_WPM), MAP_ID, 0, nullptr, tile, it - 37120, lane);
    else if (it < 45312) cvt_item64((const float*)a.in[23], DM, DM, DM / 64, (bf16_t*)(ws + WS_WO), MAP_ID, 0, nullptr, tile, it - 41216, lane);
    else if (it < 46336) cvt_item64((const float*)a.in[26], 1024, DM, 1024 / 64, (bf16_t*)(ws + WS_WMQ), MAP_ID, 0, (const float*)a.in[24], tile, it - 45312, lane);
    else                 cvt_item64((const float*)a.in[28], DM, 1024, DM / 64, (bf16_t*)(ws + WS_WMO), MAP_ID, 0, nullptr, tile, it - 46336, lane);
}

__global__ void __launch_bounds__(NWAVES * 64, 2) mk_fwd(Args args) {
    extern __shared__ __attribute__((aligned(16))) unsigned char lds[];
    Frame F;
    F.lds = (LAS unsigned char*)lds;
    constexpr int SWI_UNITS = (M / 256) * (2 * DFF / 256); const bool TAILCVT = (SWI_UNITS % (int)gridDim.x) != 0;
    volatile LAS unsigned* MISC = (volatile LAS unsigned*)(F.lds + MISC_OFF);
    F.wave = __builtin_amdgcn_readfirstlane((int)threadIdx.x >> 6);
    F.G = gridDim.x; { const int bx = blockIdx.x; F.vcu = (F.G % 8 == 0) ? (bx % 8) * (F.G / 8) + bx / 8 : bx; }
    unsigned char* ws = args.ws; unsigned char* dob = (unsigned char*)args.out;
    unsigned* ctl = (unsigned*)(ws + WS_CTL);
    for (int u = FTID; u < (LDS_BYTES - LDSCTL_OFF) / 4; u += NWAVES * 64) ((LAS unsigned*)(F.lds + LDSCTL_OFF))[u] = 0u;
    __syncthreads();
#if MK_PER_PHASE
    XcdBarrier bar; bar.bar = ctl + CW_BAR; bar.x = 0; bar.st = nullptr;
#define GRID_BAR() do { } while (0)
#else
    XcdBarrier bar = xcd_barrier_post(ctl + CW_BAR, MISC + 8, F.wave);
#define GRID_BAR() xcd_barrier(bar, F.wave)
#endif
    const int lo = args.ph_lo, hi = args.ph_hi;
#define IN(k) (lo <= (k) && (k) < hi)
#define SEAM(k) do { if (IN(k) && IN((k) + 1)) GRID_BAR(); } while (0)
    const int gw = F.vcu * NWAVES + F.wave, NGW = F.G * NWAVES;

    const float* x = (const float*)args.in[0];
    float* CS = (float*)(ws + WS_CS); bf16_t* HM = (bf16_t*)(ws + WS_HM); bf16_t* MK = (bf16_t*)(ws + WS_MK); bf16_t* MV = (bf16_t*)(ws + WS_MV);
    float* INVQ = (float*)(ws + WS_INVQ); float* INVKV = (float*)(ws + WS_INVKV); float* C2 = (float*)(ws + WS_C2); float* AGG = (float*)(ws + WS_AGG);
    bf16_t* WIN = (bf16_t*)(ws + WS_WIN); bf16_t* WG = (bf16_t*)(ws + WS_WG); bf16_t* WUQ = (bf16_t*)(ws + WS_WUQ); bf16_t* WUKV = (bf16_t*)(ws + WS_WUKV);
    bf16_t* WPL = (bf16_t*)(ws + WS_WPL); bf16_t* WPM = (bf16_t*)(ws + WS_WPM); bf16_t* WO = (bf16_t*)(ws + WS_WO); bf16_t* WMQ = (bf16_t*)(ws + WS_WMQ);
    bf16_t* WMKV = (bf16_t*)(ws + WS_WMKV); bf16_t* WMO = (bf16_t*)(ws + WS_WMO); bf16_t* WGU = (bf16_t*)(ws + WS_WGU); bf16_t* WD = (bf16_t*)(ws + WS_WD);
    bf16_t* A0 = (bf16_t*)(ws + WS_A0); bf16_t* A1 = (bf16_t*)(ws + WS_A1); bf16_t* A2 = (bf16_t*)(ws + WS_A2); bf16_t* A3 = (bf16_t*)(ws + WS_A3); bf16_t* A4 = (bf16_t*)(ws + WS_A4); bf16_t* A5 = (bf16_t*)(ws + WS_A5);
    bf16_t* D0 = (bf16_t*)(dob + DO_D0); bf16_t* D1 = (bf16_t*)(dob + DO_D1);
    bf16_t* H = D0;
    bf16_t* XA = A0; bf16_t* GGA = A1; bf16_t* SA = A2; bf16_t* SB = A3;
    bf16_t* CQ = (bf16_t*)(dob + DO_CQ); bf16_t* CKV = (bf16_t*)(dob + DO_CKV); bf16_t* KRP = (bf16_t*)(dob + DO_KRP); bf16_t* KR = (bf16_t*)(dob + DO_KR); bf16_t* QR = (bf16_t*)(dob + DO_QR);
    bf16_t* XC = WIN;
    bf16_t* QN = A4; bf16_t* KN = A5; bf16_t* VV = D0; bf16_t* YB = A4; bf16_t* T2 = A3;
    bf16_t* RF = D0; bf16_t* BTF = D1; bf16_t* RB = A0; bf16_t* BTB = A5;
    bf16_t* YA = XC  ; bf16_t* MRG = A3; bf16_t* XS = A0; bf16_t* MQ = A2; bf16_t* MO = A2 + (size_t)M * 1024; bf16_t* ACT = A3;
    float* PART1 = (float*)(ws + WS_PART1); float* PART2 = (float*)(ws + WS_PART2); float* INV1 = INVQ; float* INV2 = INVKV;

    if (IN(0)) {
        LAS unsigned* tile = (LAS unsigned*)(F.lds + F.wave * 16384);
        const int lane = FLANE;
        int base = 0;
#define CVT_JOB(SRC, LD, KK, NSRC, DST, MAP, KS) do { const int nblk_ = (NSRC) / 64, nit_ = ((KK) / 64) * nblk_; \
            for (int it = (gw - base % NGW + NGW) % NGW; it < nit_; it += NGW) cvt_item64((const float*)(SRC), (LD), (KK), nblk_, (DST), (MAP), 0, (KS), tile, it, lane); base += nit_; } while (0)
        CVT_JOB(args.in[4], IN_COLS, DM, IN_COLS, WIN, MAP_IN, nullptr);
        CVT_JOB(args.in[18], 6144, 1024, 6144, WUQ, MAP_UQ, (const float*)args.in[17]);
        CVT_JOB(args.in[20], 8192, 512, 8192, WUKV, MAP_UKV, (const float*)args.in[19]);
        CVT_JOB(args.in[27], 2048, DM, 2048, WMKV, MAP_MKV, nullptr);
#undef CVT_JOB
        for (int it = (gw - base % NGW + NGW) % NGW; it < 64 * 16; it += NGW) { const int mat = it >> 4, sub = it & 15, mi = mat >> 4, head = mat & 15, dir = mi >> 1, gate = mi & 1, nb = sub & 3;
            const float* w = (const float*)args.in[dir ? (gate ? 14 : 12) : (gate ? 9 : 7)] + (size_t)head * 65536;
            cvt_item64(w, 256, 256, 4, WG, MAP_ID, dir * 8192 + head * 512 + (nb >> 1) * 256 + gate * 128 + (nb & 1) * 64 - nb * 64, nullptr, tile, sub, lane); }
        for (size_t i = (size_t)blockIdx.x * 512 + FTID; i < (size_t)(IN_PAD - IN_COLS) * DM / 8; i += (size_t)F.G * 512) ((GAS u32x4*)(WIN + (size_t)IN_COLS * DM))[i] = (u32x4){0u, 0u, 0u, 0u};
        rms_rows<false>(F, x, (const float*)args.in[3], H, M);
        rms_rows<false>(F, (const float*)args.in[1], (const float*)args.in[25], HM, BATCH * 256);
        const int* pos = (const int*)args.in[2];
        for (int i = blockIdx.x * (NWAVES * 64) + FTID; i < M * 32; i += F.G * NWAVES * 64) {
            const int row = i >> 5, j = i & 31; const float ang = (float)pos[row] * INV_FREQ[j];
            const double t = (double)ang * 0.15915494309189535; const float fr = (float)(t - floor(t));
            CS[2 * (size_t)i] = __builtin_amdgcn_cosf(fr); CS[2 * (size_t)i + 1] = __builtin_amdgcn_sinf(fr);
        }
        for (int i = blockIdx.x * (NWAVES * 64) + FTID; i < 2 * DM; i += F.G * NWAVES * 64) {
            const float lam = ((const float*)args.in[i < DM ? 11 : 16])[i & (DM - 1)];
            C2[i] = -8.0f * log1pf(expf(-lam)) * 1.4426950408889634f;
            const int c = i & (DM - 1);
            if (i < DM) { C2[2 * DM + c] = ((const float*)args.in[8])[c]; C2[3 * DM + c] = ((const float*)args.in[10])[c]; }
            else { C2[4 * DM + c] = ((const float*)args.in[13])[c]; C2[5 * DM + c] = ((const float*)args.in[15])[c]; }
        }
    }
    SEAM(0);
    if (IN(1)) {
        { pg8::Gemm g{H, WIN, M, IN_PAD, DM, DM, DM, 0, 0}; pg8::StaticOrder S; S.init(M, IN_PAD, F.G, (int)blockIdx.x);
          pg8::EpiInProj E{XA, GGA, SA, SB, CQ, CKV, KRP};
          pg8::gemm_phase<pg8::EpiInProj>(F.lds, g, S, E, F.wave); }
        { pg8::Gemm g{HM, WMKV, 512, 2048, DM, DM, DM, 0, 0}; pg8::StaticOrder S; S.init(512, 2048, F.G, (int)((blockIdx.x + 64) % F.G));
          pg8::EpiSplit E{MK, MV, 4, 1024, nullptr};
          pg8::gemm_phase<pg8::EpiSplit>(F.lds, g, S, E, F.wave); }
    }
    SEAM(1);
    if (IN(2)) {
        for (int m = gw; m < M; m += NGW) {
            const GAS u32x4* cq = (const GAS u32x4*)(CQ + (size_t)m * 1024) + FLANE; float s = 0.f;
#pragma unroll
            for (int j = 0; j < 2; ++j) { const u32x4 w = cq[64 * j]; float a;
                a = bf_lo(w.x); s += a * a; a = bf_hi(w.x); s += a * a; a = bf_lo(w.y); s += a * a; a = bf_hi(w.y); s += a * a;
                a = bf_lo(w.z); s += a * a; a = bf_hi(w.z); s += a * a; a = bf_lo(w.w); s += a * a; a = bf_hi(w.w); s += a * a; }
            s = wave_sum(s);
            float s2 = 0.f; { const u32x4 w = ((const GAS u32x4*)(CKV + (size_t)m * 512))[FLANE]; float a;
                a = bf_lo(w.x); s2 += a * a; a = bf_hi(w.x); s2 += a * a; a = bf_lo(w.y); s2 += a * a; a = bf_hi(w.y); s2 += a * a;
                a = bf_lo(w.z); s2 += a * a; a = bf_hi(w.z); s2 += a * a; a = bf_lo(w.w); s2 += a * a; a = bf_hi(w.w); s2 += a * a; }
            s2 = wave_sum(s2);
            if (FLANE == 0) { INVQ[m] = (0.07216878364870322f * 1.4426950408889634f) / sqrtf(s * (1.f / 1024.f) + EPS); INVKV[m] = 1.0f / sqrtf(s2 * (1.f / 512.f) + EPS); }
            if (FLANE < 32) { const float t1 = bf2f(KRP[(size_t)m * 64 + FLANE]), t2 = bf2f(KRP[(size_t)m * 64 + 32 + FLANE]);
                const float c = CS[((size_t)m * 32 + FLANE) * 2], sn = CS[((size_t)m * 32 + FLANE) * 2 + 1];
                ((GAS unsigned*)(KR + (size_t)m * 64))[FLANE] = cvt_pk_bf16(t1 * c - t2 * sn, t2 * c + t1 * sn); }
        }
        { const int seg = gw & 7, lane = FLANE, ch0 = seg * 512 + lane * 8; const float* cw = (const float*)args.in[5]; const float* cb = (const float*)args.in[6];
          float w[4][8], bsv[8];
#pragma unroll
          for (int k = 0; k < 4; ++k)
#pragma unroll
              for (int i = 0; i < 8; ++i) w[k][i] = cw[k * DM + ch0 + i];
#pragma unroll
          for (int i = 0; i < 8; ++i) bsv[i] = cb[ch0 + i];
          for (int rb = gw >> 3; rb < M / 64; rb += NGW >> 3) { const int r0 = rb * 64, s0 = r0 & (SEQ - 1);
              const u32x4 z4 = {0u, 0u, 0u, 0u};
              u32x4 pm2 = s0 >= 2 ? *(const GAS u32x4*)(XA + (size_t)(r0 - 2) * DM + ch0) : z4, pm1 = s0 >= 1 ? *(const GAS u32x4*)(XA + (size_t)(r0 - 1) * DM + ch0) : z4;
              u32x4 cur = *(const GAS u32x4*)(XA + (size_t)r0 * DM + ch0);
              for (int t0 = 0; t0 < 64; t0 += 8) { u32x4 nx[8];
#pragma unroll
                  for (int i = 0; i < 8; ++i) { const int s = s0 + t0 + i + 1; nx[i] = s < SEQ ? *(const GAS u32x4*)(XA + (size_t)(r0 + t0 + i + 1) * DM + ch0) : z4; }
#pragma unroll
                  for (int i = 0; i < 8; ++i) { const u32x4 tp[4] = {pm2, pm1, cur, nx[i]}; float o[8];
#pragma unroll
                      for (int c = 0; c < 8; ++c) o[c] = bsv[c];
#pragma unroll
                      for (int k = 0; k < 4; ++k) { const u32x4 v = tp[k];
                          o[0] += w[k][0] * bf_lo(v.x); o[1] += w[k][1] * bf_hi(v.x); o[2] += w[k][2] * bf_lo(v.y); o[3] += w[k][3] * bf_hi(v.y);
                          o[4] += w[k][4] * bf_lo(v.z); o[5] += w[k][5] * bf_hi(v.z); o[6] += w[k][6] * bf_lo(v.w); o[7] += w[k][7] * bf_hi(v.w); }
                      u32x4 ow; ow.x = cvt_pk_bf16(o[0], o[1]); ow.y = cvt_pk_bf16(o[2], o[3]); ow.z = cvt_pk_bf16(o[4], o[5]); ow.w = cvt_pk_bf16(o[6], o[7]);
                      *(GAS u32x4*)(XC + (size_t)(r0 + t0 + i) * DM + ch0) = ow;
                      pm2 = pm1; pm1 = cur; cur = nx[i]; } } } }
    }
    SEAM(2);
    if (IN(3)) {
        { pg8::Gemm g{CQ, WUQ, M, 6144, 1024, 1024, 1024, 0, 0}; pg8::StaticOrder S; S.init(M, 6144, F.G, (int)blockIdx.x);
          pg8::EpiQ E{QN, QR, INVQ, CS};
          pg8::gemm_phase<pg8::EpiQ>(F.lds, g, S, E, F.wave); }
        { pg8::Gemm g{CKV, WUKV, M, 8192, 512, 512, 512, 0, 0}; pg8::StaticOrder S; S.init(M, 8192, F.G, (int)blockIdx.x);
          pg8::EpiSplit E{KN, VV, 16, DM, INVKV};
          pg8::gemm_phase<pg8::EpiSplit>(F.lds, g, S, E, F.wave); }
    }
    SEAM(3);
    if (IN(4)) {
        const int ndef4 = TAILCVT ? NDEF - 11008 : NDEF;
        const int nunits = BATCH * NH * (SEQ / 256), nslots = (nunits + F.G - 1) / F.G, ips = (ndef4 + NGW * nslots - 1) / (NGW * nslots); int slot = 0;
        for (int L = F.vcu; L < nunits; L += F.G, ++slot) {
            const int bh = L >> 5, qb = L & 31, b = bh >> 5, h = bh & 31; const size_t r0 = (size_t)b * SEQ + (size_t)qb * 256, k0 = (size_t)b * SEQ;
            att::attn_unit_dma<att::Cfg<2, 1, 3, 0, DM, 2048, DM, 64, DM, DM, SEQ>>(QN + r0 * DM + h * 128, QR + r0 * 2048 + h * 64, KN + k0 * DM + h * 128, KR + k0 * 64,
                                       VV + k0 * DM + h * 128, YB + r0 * DM + h * 128, 8.0f * 1.4426950408889634f, (char*)lds, F.lds, F.wave);
            __syncthreads();
            { LAS unsigned* tile = (LAS unsigned*)(F.lds + F.wave * 16384); const int lane = FLANE;
              for (int i = 0; i < ips; ++i) { const int u = gw + NGW * (slot * ips + i); if (u < ndef4) cvt_deferred(args, ws, (TAILCVT && u >= 22016) ? u + 11008 : u, tile, lane); } }
        }
        __syncthreads();
    }
    SEAM(4);
    if (IN(5)) {
        { pg8::Gemm g{XC, WG, M, 16384, 256, DM, 256, 1, 15}; pg8::StaticOrder S; S.init(M, 16384, F.G, (int)blockIdx.x);
          pg8::EpiGates E{XC, ws, dob, C2};
          pg8::gemm_phase<pg8::EpiGates>(F.lds, g, S, E, F.wave); }
    }
    SEAM(5);
    const int NSC = (F.G % 8 == 0) ? ((F.G * 5 / 16) & ~7) : F.G * 5 / 16, NGE = F.G - NSC;
    const bool scanrole = (int)blockIdx.x >= NGE; const int sgw = ((int)blockIdx.x - NGE) * NWAVES + F.wave, SNGW = NSC * NWAVES;
    if (IN(6) && !scanrole) {
        pg8::Gemm g{YB, WPM, M, DM, DM, DM, DM, 0, 0}; pg8::StaticOrder S; S.init(M, DM, NGE, (int)blockIdx.x);
        pg8::EpiGateMul<false> E{SB, T2};
        pg8::gemm_phase<pg8::EpiGateMul<false>>(F.lds, g, S, E, F.wave);
    }
    if (IN(6) && scanrole) {
        const int lane = FLANE;
        for (int it = sgw; it < 2 * BATCH * SCAN_NC * 16; it += SNGW) {
            const int chg = it & 15, ck = (it >> 4) & (SCAN_NC - 1), b = (it >> 10) & 1, dir = it >> 11, ch = chg * 256 + lane * 4;
            const bf16_t* Rp = dir ? RB : RF; const bf16_t* Bp = dir ? BTB : BTF;
            const f32x4 cc = *(const GAS f32x4*)(C2 + dir * DM + ch);
            f32x4 P = {1.f, 1.f, 1.f, 1.f}, hh = {0.f, 0.f, 0.f, 0.f};
            const size_t rowb = (size_t)b * SEQ + (size_t)ck * SCAN_L;
            const bool head = dir ? ck == SCAN_NC - 1 : ck == 0;
            for (int t0 = 0; t0 < SCAN_L; t0 += 32) { u32x2 rw[32], bw[32];
#pragma unroll
                for (int i = 0; i < 32; ++i) { const size_t row = rowb + (dir ? SCAN_L - 1 - (t0 + i) : t0 + i); rw[i] = *(const GAS u32x2*)(Rp + row * DM + ch); bw[i] = *(const GAS u32x2*)(Bp + row * DM + ch); }
#pragma unroll
                for (int i = 0; i < 32; ++i) {
                    f32x4 a; a.x = __builtin_amdgcn_exp2f(cc.x * bf_lo(rw[i].x)); a.y = __builtin_amdgcn_exp2f(cc.y * bf_hi(rw[i].x)); a.z = __builtin_amdgcn_exp2f(cc.z * bf_lo(rw[i].y)); a.w = __builtin_amdgcn_exp2f(cc.w * bf_hi(rw[i].y));
                    f32x4 bt = {bf_lo(bw[i].x), bf_hi(bw[i].x), bf_lo(bw[i].y), bf_hi(bw[i].y)};
                    if (!(head && t0 == 0 && i == 0)) bt = bt * mult_of(a);
                    P = P * a; hh = a * hh + bt; } }
            GAS f32x4* ag = (GAS f32x4*)(AGG + ((((size_t)dir * BATCH + b) * SCAN_NC + ck) * DM + ch) * 2);
            ag[0] = (f32x4){P.x, hh.x, P.y, hh.y}; ag[1] = (f32x4){P.z, hh.z, P.w, hh.w};
        }
    }
    if (IN(6) && scanrole && IN(7)) {
        asm volatile("s_waitcnt vmcnt(0)" ::: "memory"); __syncthreads();
        if (F.wave == 0 && lane_id() == 0) { unsigned* sb_ = ctl + CW_SUB;
            __builtin_amdgcn_fence(__ATOMIC_RELEASE, "agent"); asm volatile("s_waitcnt vmcnt(0)" ::: "memory");
            (void)xb_add(sb_, 1u);
            XB_SPIN(xb_ld(sb_) < (unsigned)NSC, ctl + CW_BAR);
            __builtin_amdgcn_fence(__ATOMIC_ACQUIRE, "agent"); asm volatile("s_waitcnt vmcnt(0)" ::: "memory"); }
        __syncthreads();
    }
    if (!(IN(6) && IN(7))) SEAM(6);
    if (IN(7) && (scanrole || !IN(6))) {
        const int lane = FLANE;
        const int gw7 = IN(6) ? sgw : gw, ngw7 = IN(6) ? SNGW : NGW;
        for (int it = gw7; it < BATCH * SCAN_NC * 16; it += ngw7) {
            const int chg = it & 15, ck = (it >> 4) & (SCAN_NC - 1), b = it >> 10, ch = chg * 256 + lane * 4;
            f32x4 cf = {0.f, 0.f, 0.f, 0.f}, cbk = {0.f, 0.f, 0.f, 0.f};
            for (int k = 0; k < ck; ++k) { const GAS f32x4* ag = (const GAS f32x4*)(AGG + ((((size_t)0 * BATCH + b) * SCAN_NC + k) * DM + ch) * 2); const f32x4 u0 = ag[0], u1 = ag[1];
                cf.x = u0.x * cf.x + u0.y; cf.y = u0.z * cf.y + u0.w; cf.z = u1.x * cf.z + u1.y; cf.w = u1.z * cf.w + u1.w; }
            for (int k = SCAN_NC - 1; k > ck; --k) { const GAS f32x4* ag = (const GAS f32x4*)(AGG + ((((size_t)1 * BATCH + b) * SCAN_NC + k) * DM + ch) * 2); const f32x4 u0 = ag[0], u1 = ag[1];
                cbk.x = u0.x * cbk.x + u0.y; cbk.y = u0.z * cbk.y + u0.w; cbk.z = u1.x * cbk.z + u1.y; cbk.w = u1.z * cbk.w + u1.w; }
            const f32x4 ccf = *(const GAS f32x4*)(C2 + ch), ccb = *(const GAS f32x4*)(C2 + DM + ch);
            const size_t rowb = (size_t)b * SEQ + (size_t)ck * SCAN_L;
            f32x4 hh = cbk;
            for (int t0 = SCAN_L - 32; t0 >= 0; t0 -= 32) { u32x2 rw[32], bw[32];
#pragma unroll
                for (int i = 0; i < 32; ++i) { const size_t row = rowb + t0 + 31 - i; rw[i] = *(const GAS u32x2*)(RB + row * DM + ch); bw[i] = *(const GAS u32x2*)(BTB + row * DM + ch); }
#pragma unroll
                for (int i = 0; i < 32; ++i) { const size_t row = rowb + t0 + 31 - i;
                    f32x4 a; a.x = __builtin_amdgcn_exp2f(ccb.x * bf_lo(rw[i].x)); a.y = __builtin_amdgcn_exp2f(ccb.y * bf_hi(rw[i].x)); a.z = __builtin_amdgcn_exp2f(ccb.z * bf_lo(rw[i].y)); a.w = __builtin_amdgcn_exp2f(ccb.w * bf_hi(rw[i].y));
                    f32x4 bt = {bf_lo(bw[i].x), bf_hi(bw[i].x), bf_lo(bw[i].y), bf_hi(bw[i].y)};
                    if (!(ck == SCAN_NC - 1 && t0 == SCAN_L - 32 && i == 0)) bt = bt * mult_of(a);
                    hh = a * hh + bt;
                    u32x2 ow; ow.x = cvt_pk_bf16(hh.x, hh.y); ow.y = cvt_pk_bf16(hh.z, hh.w); *(GAS u32x2*)(YA + row * DM + ch) = ow; } }
            VM_WAIT();
            hh = cf;
            for (int t0 = 0; t0 < SCAN_L; t0 += 16) { u32x2 rw[16], bw[16], yw[16], gg2[16];
#pragma unroll
                for (int i = 0; i < 16; ++i) { const size_t row = rowb + t0 + i; rw[i] = *(const GAS u32x2*)(RF + row * DM + ch); bw[i] = *(const GAS u32x2*)(BTF + row * DM + ch);
                    yw[i] = *(const GAS u32x2*)(YA + row * DM + ch); gg2[i] = *(const GAS u32x2*)(GGA + row * DM + ch); }
#pragma unroll
                for (int i = 0; i < 16; ++i) { const size_t row = rowb + t0 + i;
                    f32x4 a; a.x = __builtin_amdgcn_exp2f(ccf.x * bf_lo(rw[i].x)); a.y = __builtin_amdgcn_exp2f(ccf.y * bf_hi(rw[i].x)); a.z = __builtin_amdgcn_exp2f(ccf.z * bf_lo(rw[i].y)); a.w = __builtin_amdgcn_exp2f(ccf.w * bf_hi(rw[i].y));
                    f32x4 bt = {bf_lo(bw[i].x), bf_hi(bw[i].x), bf_lo(bw[i].y), bf_hi(bw[i].y)};
                    if (!(ck == 0 && t0 == 0 && i == 0)) bt = bt * mult_of(a);
                    hh = a * hh + bt;
                    const f32x4 hb = {bf_lo(yw[i].x), bf_hi(yw[i].x), bf_lo(yw[i].y), bf_hi(yw[i].y)}, gg = {bf_lo(gg2[i].x), bf_hi(gg2[i].x), bf_lo(gg2[i].y), bf_hi(gg2[i].y)};
                    const f32x4 y = gg * (hh + hb);
                    u32x2 ow; ow.x = cvt_pk_bf16(y.x, y.y); ow.y = cvt_pk_bf16(y.z, y.w); *(GAS u32x2*)(YA + row * DM + ch) = ow; } }
        }
    }
    SEAM(7);
    if (IN(8)) {
        pg8::Gemm g{YA, WPL, M, DM, DM, DM, DM, 0, 0}; pg8::StaticOrder S; S.init(M, DM, F.G, (int)blockIdx.x);
        pg8::EpiGateMul<true> E{SA, MRG};
        pg8::gemm_phase<pg8::EpiGateMul<true>>(F.lds, g, S, E, F.wave);
    }
    SEAM(8);
    if (IN(9)) {
        pg8::Gemm g{MRG, WO, M, DM, DM, DM, DM, 0, 0}; pg8::StaticOrder S; S.init(M, DM, F.G, (int)blockIdx.x);
        pg8::EpiResidBf<true, true> E{x, XS, PART1};
        pg8::gemm_phase<pg8::EpiResidBf<true, true>>(F.lds, g, S, E, F.wave);
    }
    SEAM(9);
    if (IN(10)) inv_rows(F, PART1, INV1, 0.0625f * 1.4426950408889634f);
    SEAM(10);
    if (IN(11)) {
        pg8::Gemm g{XS, WMQ, M, 1024, DM, DM, DM, 0, 0}; pg8::StaticOrder S; S.init(M, 1024, F.G, (int)blockIdx.x);
        pg8::EpiSplit E{MQ, MQ, 1 << 20, 1024, INV1};
        pg8::gemm_phase<pg8::EpiSplit>(F.lds, g, S, E, F.wave);
    }
    SEAM(11);
    if (IN(12)) {
        for (int L = F.vcu; L < BATCH * 4 * 2 * (SEQ / 256); L += F.G) {
            const int grp = L >> 5, qb = L & 31, b = grp >> 3, mh = (grp >> 1) & 3, vh = grp & 1; const size_t r0 = (size_t)b * SEQ + (size_t)qb * 256, k0 = (size_t)b * 256;
            att::attn_unit<att::Cfg<4, 0, 0, 0, 1024, 1024, 1024, 1024, 1024, 1024, 256>>(MQ + r0 * 1024 + mh * 256, MQ, MK + k0 * 1024 + mh * 256, MK,
                                        MV + k0 * 1024 + mh * 256 + vh * 128, MO + r0 * 1024 + mh * 256 + vh * 128, 8.0f * 1.4426950408889634f, (char*)lds, F.wave);
        }
        __syncthreads();
    }
    SEAM(12);
    if (IN(13)) {
        pg8::Gemm g{MO, WMO, M, DM, 1024, 1024, 1024, 0, 0}; pg8::StaticOrder S; S.init(M, DM, F.G, (int)blockIdx.x);
        pg8::EpiResidBf<false, true> E{nullptr, XS, PART2};
        pg8::gemm_phase<pg8::EpiResidBf<false, true>>(F.lds, g, S, E, F.wave);
    }
    SEAM(13);
    if (IN(14)) inv_rows(F, PART2, INV2, 1.f);
    SEAM(14);
    if (IN(15)) {
        pg8::Gemm g{XS, WGU, M, 2 * DFF, DM, DM, DM, 0, 0}; pg8::StaticOrder S; S.init(M, 2 * DFF, F.G, (int)blockIdx.x);
        pg8::EpiSwiglu E{ACT, INV2};
        pg8::gemm_phase<pg8::EpiSwiglu>(F.lds, g, S, E, F.wave);
        if (TAILCVT && (int)blockIdx.x >= SWI_UNITS % F.G) {
            __syncthreads();
            LAS unsigned* tile = (LAS unsigned*)(F.lds + F.wave * 16384); const int lane = FLANE, rem = SWI_UNITS % F.G, nw = (F.G - rem) * NWAVES;
            for (int it = ((int)blockIdx.x - rem) * NWAVES + F.wave; it < 11008; it += nw) cvt_deferred(args, ws, 22016 + it, tile, lane); }
    }
    SEAM(15);
    if (IN(16)) {
        pg8::Gemm g{ACT, WD, M, DM, DFF, DFF, DFF, 0, 0}; pg8::StaticOrder S; S.init(M, DM, F.G, (int)blockIdx.x);
        pg8::EpiResidBf<false, false> E{nullptr, XS, nullptr};
        pg8::gemm_phase<pg8::EpiResidBf<false, false>>(F.lds, g, S, E, F.wave);
    }
    SEAM(16);
    if (IN(17)) rms_rows_bf(F, XS, (const float*)args.in[33], args.out, M);
#undef IN
#undef SEAM
}

extern "C" void kernel_launch(void* const* d_in, const int* in_sizes, int n_in, void* d_out, int out_size, void* d_ws, size_t ws_size, hipStream_t stream) {
    static int grid = 0;
    if (grid == 0) {
        if (n_in != 34 || in_sizes[0] != M * DM || out_size != M * DM || ws_size < WS_END) {
            fprintf(stderr, "kernel_launch: shape/workspace mismatch: n_in %d in0 %d out %d ws %zu (need %zu); nothing launched\n", n_in, n_in > 0 ? in_sizes[0] : -1, out_size, ws_size, (size_t)WS_END);
            grid = -1; return; }
        int dev = 0, cus = 0, per_cu = 0;
        if (hipGetDevice(&dev) != hipSuccess || hipDeviceGetAttribute(&cus, hipDeviceAttributeMultiprocessorCount, dev) != hipSuccess) { grid = -1; return; }
        if (hipFuncSetAttribute((const void*)mk_fwd, hipFuncAttributeMaxDynamicSharedMemorySize, LDS_BYTES) != hipSuccess) { fprintf(stderr, "kernel_launch: hipFuncSetAttribute failed\n"); grid = -1; return; }
        if (hipOccupancyMaxActiveBlocksPerMultiprocessor(&per_cu, (const void*)mk_fwd, NWAVES * 64, LDS_BYTES) != hipSuccess || per_cu < 1)
            fprintf(stderr, "kernel_launch: note: occupancy query reports %d workgroups per CU\n", per_cu);
        (void)hipGetLastError();
        grid = cus;
    }
    if (grid < 0) return;
    if (hipMemsetAsync((char*)d_ws + WS_CTL, 0, CTL_ZERO_BYTES, stream) != hipSuccess) { fprintf(stderr, "kernel_launch: memset failed\n"); return; }
    Args a{};
    for (int i = 0; i < 34; ++i) a.in[i] = d_in[i];
    a.out = (float*)d_out; a.ws = (unsigned char*)d_ws;
#if MK_PER_PHASE
    for (int p = 0; p < NPHASE; ++p) { a.ph_lo = p; a.ph_hi = p + 1; hipLaunchKernelGGL(mk_fwd, dim3(grid), dim3(NWAVES * 64), LDS_BYTES, stream, a); }
#else
    a.ph_lo = 0; a.ph_hi = NPHASE; hipLaunchKernelGGL(mk_fwd, dim3(grid), dim3(NWAVES * 64), LDS_BYTES, stream, a);
#endif
    const hipError_t le = hipPeekAtLastError();
    if (le != hipSuccess) fprintf(stderr, "kernel_launch: launch failed: %s\n", hipGetErrorName(le));
}
```

```cpp
#include <hip/hip_runtime.h>
#include <cstdio>
#include <cstdint>

#define LAS __attribute__((address_space(3)))
#define GAS __attribute__((address_space(1)))
typedef unsigned short bf16_t;
typedef short bf16x8 __attribute__((ext_vector_type(8)));
typedef short s16x4 __attribute__((ext_vector_type(4)));
typedef float f32x2 __attribute__((ext_vector_type(2)));
typedef float f32x4 __attribute__((ext_vector_type(4)));
typedef float f32x16 __attribute__((ext_vector_type(16)));
typedef unsigned u32x2 __attribute__((ext_vector_type(2)));
typedef unsigned u32x4 __attribute__((ext_vector_type(4)));

#ifndef MK_PER_PHASE
#define MK_PER_PHASE 0
#endif

constexpr int BATCH = 2, SEQ = 8192, DM = 4096, M = BATCH * SEQ;
constexpr int NH = 32, DFF = 11008;
constexpr int IN_COLS = 17984, IN_PAD = 18176;
constexpr float EPS = 1e-6f;
constexpr int NWAVES = 8;
constexpr int NPHASE = 18;
constexpr int SCAN_L = 128, SCAN_NC = SEQ / SCAN_L;

constexpr size_t MiB = 1u << 20;
constexpr size_t WS_CTL = 0, CTL_ZERO_BYTES = 1 * MiB;
constexpr size_t WS_CS = 1 * MiB;
constexpr size_t WS_HM = 5 * MiB;
constexpr size_t WS_MK = 9 * MiB;
constexpr size_t WS_MV = 10 * MiB;
constexpr size_t WS_INVQ = 11 * MiB;
constexpr size_t WS_INVKV = 11 * MiB + 256 * 1024;
constexpr size_t WS_C2 = 11 * MiB + 512 * 1024;
constexpr size_t WS_AGG = 12 * MiB;
constexpr size_t WS_PART1 = 20 * MiB, WS_PART2 = 24 * MiB;
constexpr size_t WS_W = 33 * MiB;
constexpr size_t WS_WIN = WS_W;
constexpr size_t WS_WG = WS_WIN + 142 * MiB;
constexpr size_t WS_WUQ = WS_WG + 8 * MiB;
constexpr size_t WS_WUKV = WS_WUQ + 12 * MiB;
constexpr size_t WS_WPL = WS_WUKV + 8 * MiB;
constexpr size_t WS_WPM = WS_WPL + 32 * MiB;
constexpr size_t WS_WO = WS_WPM + 32 * MiB;
constexpr size_t WS_WMQ = WS_WO + 32 * MiB;
constexpr size_t WS_WMKV = WS_WMQ + 8 * MiB;
constexpr size_t WS_WMO = WS_WMKV + 16 * MiB;
constexpr size_t WS_WGU = WS_WMO + 8 * MiB;
constexpr size_t WS_WD = WS_WGU + 172 * MiB;
constexpr size_t WS_A0 = WS_WD + 86 * MiB;
constexpr size_t PLANE = 128 * MiB;
constexpr size_t WS_A1 = WS_A0 + PLANE, WS_A2 = WS_A1 + PLANE, WS_A3 = WS_A2 + PLANE, WS_A4 = WS_A3 + PLANE, WS_A5 = WS_A4 + PLANE;
constexpr size_t WS_END = WS_A5 + PLANE;
static_assert(WS_A0 == 589 * MiB && WS_END == 1357 * MiB, "ws map");
constexpr size_t DO_D0 = 0, DO_D1 = PLANE;
constexpr size_t DO_CQ = DO_D1, DO_CKV = DO_D1 + 32 * MiB, DO_KRP = DO_D1 + 48 * MiB, DO_KR = DO_D1 + 50 * MiB, DO_QR = DO_D1 + 64 * MiB;

constexpr int CW_BAR = 4096;

constexpr int RING_BYTES = 131072;
constexpr int LDSCTL_OFF = RING_BYTES, MISC_OFF = LDSCTL_OFF + 320;
constexpr int LDS_BYTES = 147456;

__device__ const float INV_FREQ[32] = {
    1.000000000e+00f, 7.498942018e-01f, 5.623413324e-01f, 4.216965139e-01f, 3.162277639e-01f, 2.371373773e-01f, 1.778279394e-01f, 1.333521456e-01f,
    1.000000015e-01f, 7.498942316e-02f, 5.623413250e-02f, 4.216964915e-02f, 3.162277490e-02f, 2.371373773e-02f, 1.778279431e-02f, 1.333521400e-02f,
    9.999999776e-03f, 7.498942316e-03f, 5.623413250e-03f, 4.216964822e-03f, 3.162277630e-03f, 2.371373819e-03f, 1.778279431e-03f, 1.333521446e-03f,
    1.000000047e-03f, 7.498941850e-04f, 5.623413017e-04f, 4.216965172e-04f, 3.162277571e-04f, 2.371373703e-04f, 1.778279402e-04f, 1.333521504e-04f};

typedef __bf16 bf16x2_t __attribute__((ext_vector_type(2)));
__device__ __forceinline__ unsigned cvt_pk_bf16(float lo, float hi) { const f32x2 v = {lo, hi}; const bf16x2_t b = __builtin_convertvector(v, bf16x2_t); return __builtin_bit_cast(unsigned, b); }
__device__ __forceinline__ float bf_lo(unsigned w) { return __uint_as_float(w << 16); }
__device__ __forceinline__ float bf_hi(unsigned w) { return __uint_as_float(w & 0xffff0000u); }
__device__ __forceinline__ float bf2f(bf16_t b) { return __uint_as_float((unsigned)b << 16); }
__device__ __forceinline__ unsigned f2bf(float f) { unsigned u = __builtin_bit_cast(unsigned, f); return (u + 0x7fffu + ((u >> 16) & 1u)) >> 16; }
__device__ __forceinline__ unsigned pk2(float lo, float hi) { return f2bf(lo) | (f2bf(hi) << 16); }
__device__ __forceinline__ float sigm(float z) { return __builtin_amdgcn_rcpf(1.f + __builtin_amdgcn_exp2f(-1.4426950408889634f * z)); }
__device__ __forceinline__ f32x4 mult_of(const f32x4 a) {
    f32x4 m;
#pragma unroll
    for (int i = 0; i < 4; ++i) m[i] = __builtin_amdgcn_sqrtf(fmaxf(1.f - a[i] * a[i], 0.f));
    return m; }
__device__ __forceinline__ float gelu_tanh(float x) { const float u = 0.7978845608028654f * (x + 0.044715f * x * x * x); return x * sigm(2.f * u); }
__device__ __forceinline__ float silu(float x) { return x * sigm(x); }
__device__ __forceinline__ float wave_sum(float v) {
#pragma unroll
    for (int o = 1; o < 64; o <<= 1) v += __shfl_xor(v, o);
    return v;
}
__device__ __forceinline__ int lane_id() { int l; asm volatile("v_mbcnt_lo_u32_b32 %0, -1, 0\n\tv_mbcnt_hi_u32_b32 %0, -1, %0" : "=v"(l)); return l; }
__device__ __forceinline__ int fresh_tid(int wave) { int t = wave * 64 + lane_id(); asm volatile("" : "+v"(t)); return t; }
#define LDS_WAIT() asm volatile("s_waitcnt lgkmcnt(0)" ::: "memory")
#define VM_WAIT() asm volatile("s_waitcnt vmcnt(0)" ::: "memory")

namespace pg8 {
constexpr int BM = 256, BK = 64, HALF = 128, HTB = HALF * BK * 2, STAGE_BYTES = 8 * HTB, NXCD = 8, WGM = 8;
__host__ __device__ __forceinline__ int lds_byte(int r, int c) { const int st = (r >> 4) * 2 + (c >> 5), rr = r & 15, cc = c & 31, ob = rr * 64 + cc * 2; return st * 1024 + (ob ^ (((ob >> 9) & 1) << 5)); }
__host__ __device__ __forceinline__ void stage_rc(int b, int& R, int& C) { const int st = b / 1024, sb = b % 1024, swz = sb ^ (((sb >> 9) & 1) << 5); R = (st >> 1) * 16 + swz / 64; C = (st & 1) * 32 + (swz % 64) / 2; }
__host__ __device__ __forceinline__ int perm32(int rho) { const int n = rho >> 4, i = rho & 15; return 8 * (i >> 2) + 4 * n + (i & 3); }

struct Unit { int pm, pn; };
struct Gemm { const bf16_t* A; const bf16_t* Bt; int M, N, K, lda, ldb, a_shift, a_mask; };

struct StaticOrder {
    int nM, nN, nwg, G, c;
    __host__ __device__ void init(int M_, int N_, int G_, int c_) { nM = M_ / BM; nN = N_ / BM; nwg = nM * nN; G = G_; c = c_; }
    __host__ __device__ bool next(int i, Unit& u) const {
        const long L = (long)i * G + c; if (L >= nwg) return false;
        int wgid = (int)L; { const int q = nwg / NXCD, r = nwg % NXCD, xcd = wgid % NXCD, off = wgid / NXCD; wgid = (xcd < r ? xcd * (q + 1) : r * (q + 1) + (xcd - r) * q) + off; }
        const int nig = WGM * nN, gid = wgid / nig, fm = gid * WGM, gsz = (nM - fm) < WGM ? (nM - fm) : WGM;
        u.pm = fm + ((wgid % nig) % gsz); u.pn = (wgid % nig) / gsz; return true;
    }
};

typedef f32x4 Acc[2][2][4][2];

__device__ __forceinline__ u32x4 pack8(f32x4 v0, f32x4 v1) { u32x4 w; w.x = cvt_pk_bf16(v0[0], v0[1]); w.y = cvt_pk_bf16(v0[2], v0[3]); w.z = cvt_pk_bf16(v1[0], v1[1]); w.w = cvt_pk_bf16(v1[2], v1[3]); return w; }

template <int ACT  >
__device__ __forceinline__ void store_tile_bf16(const Acc& acc, bf16_t* dst, int ldc, int colt, int ncol, int pm, int wr, int wc, int fr, int fq, const float* rowscale) {
    const int row0 = pm * BM + wr * 64 + fr, cl = wc * 32 + 8 * fq;
#pragma unroll
    for (int ai = 0; ai < 2; ++ai)
#pragma unroll
        for (int m = 0; m < 4; ++m) { const int row = row0 + ai * HALF + m * 16; bf16_t* rowp = dst + (size_t)row * ldc + colt + cl;
            const float rs = rowscale ? rowscale[row] : 1.f;
#pragma unroll
            for (int bj = 0; bj < 2; ++bj) { if (bj * HALF + cl < ncol) { f32x4 v0 = acc[ai][bj][m][0], v1 = acc[ai][bj][m][1];
                if (ACT == 1) {
#pragma unroll
                    for (int i = 0; i < 4; ++i) { v0[i] = gelu_tanh(v0[i]); v1[i] = gelu_tanh(v1[i]); } }
                if (ACT == 2) {
#pragma unroll
                    for (int i = 0; i < 4; ++i) { v0[i] = sigm(v0[i]); v1[i] = sigm(v1[i]); } }
                v0 = v0 * rs; v1 = v1 * rs;
                *(u32x4*)(rowp + bj * HALF) = pack8(v0, v1); } } }
}

struct EpiInProj { static constexpr bool PERM = true;
    bf16_t *XA, *GGA, *SA, *SB, *CQ, *CKV, *KRP;
    __device__ __forceinline__ void operator()(const Acc& acc, const Unit& u, int wr, int wc, int fr, int fq) const {
        const int pn = u.pn;
        if (pn < 16) store_tile_bf16<0>(acc, XA, DM, pn * 256, 256, u.pm, wr, wc, fr, fq, nullptr);
        else if (pn < 32) store_tile_bf16<1>(acc, GGA, DM, (pn - 16) * 256, 256, u.pm, wr, wc, fr, fq, nullptr);
        else if (pn < 48) store_tile_bf16<2>(acc, SA, DM, (pn - 32) * 256, 256, u.pm, wr, wc, fr, fq, nullptr);
        else if (pn < 64) store_tile_bf16<2>(acc, SB, DM, (pn - 48) * 256, 256, u.pm, wr, wc, fr, fq, nullptr);
        else if (pn < 68) store_tile_bf16<0>(acc, CQ, 1024, (pn - 64) * 256, 256, u.pm, wr, wc, fr, fq, nullptr);
        else if (pn < 70) store_tile_bf16<0>(acc, CKV, 512, (pn - 68) * 256, 256, u.pm, wr, wc, fr, fq, nullptr);
        else store_tile_bf16<0>(acc, KRP, 64, 0, 64, u.pm, wr, wc, fr, fq, nullptr);
    }
};
struct EpiSplit { static constexpr bool PERM = true;
    bf16_t *D0, *D1; int split, ldc; const float* rowscale;
    __device__ __forceinline__ void operator()(const Acc& acc, const Unit& u, int wr, int wc, int fr, int fq) const {
        if (u.pn < split) store_tile_bf16<0>(acc, D0, ldc, u.pn * 256, 256, u.pm, wr, wc, fr, fq, rowscale);
        else store_tile_bf16<0>(acc, D1, ldc, (u.pn - split) * 256, 256, u.pm, wr, wc, fr, fq, rowscale);
    }
};
struct EpiQ { static constexpr bool PERM = true;
    bf16_t *QN, *QR; const float* invq; const float* cs;
    __device__ __forceinline__ void operator()(const Acc& acc, const Unit& u, int wr, int wc, int fr, int fq) const {
        if (u.pn < 16) { store_tile_bf16<0>(acc, QN, DM, u.pn * 256, 256, u.pm, wr, wc, fr, fq, invq); return; }
        const int row0 = u.pm * BM + wr * 64 + fr, cl = wc * 32 + 8 * fq, colt = (u.pn - 16) * 256;
#pragma unroll
        for (int ai = 0; ai < 2; ++ai)
#pragma unroll
            for (int m = 0; m < 4; ++m) { const int row = row0 + ai * HALF + m * 16; const float rs = invq[row];
#pragma unroll
                for (int bj = 0; bj < 2; ++bj) { const int c = colt + bj * HALF + cl;
                    const int j0 = (c & 63) >> 1; const f32x4* cp = (const f32x4*)(cs + ((size_t)row * 32 + j0) * 2);
                    const f32x4 c0 = cp[0], c1 = cp[1];
                    f32x4 v0 = acc[ai][bj][m][0] * rs, v1 = acc[ai][bj][m][1] * rs, o0, o1;
                    o0[0] = v0[0] * c0[0] - v0[1] * c0[1]; o0[1] = v0[1] * c0[0] + v0[0] * c0[1];
                    o0[2] = v0[2] * c0[2] - v0[3] * c0[3]; o0[3] = v0[3] * c0[2] + v0[2] * c0[3];
                    o1[0] = v1[0] * c1[0] - v1[1] * c1[1]; o1[1] = v1[1] * c1[0] + v1[0] * c1[1];
                    o1[2] = v1[2] * c1[2] - v1[3] * c1[3]; o1[3] = v1[3] * c1[2] + v1[2] * c1[3];
                    *(u32x4*)(QR + (size_t)row * 2048 + c) = pack8(o0, o1); } }
    }
};
struct EpiGates { static constexpr bool PERM = true;
    const bf16_t* XC; unsigned char* ws; unsigned char* dob; const float* tab;
    __device__ __forceinline__ void operator()(const Acc& acc, const Unit& u, int wr, int wc, int fr, int fq) const {
        const int dir = u.pn >> 5, chb = ((u.pn >> 1) & 15) * 256 + (u.pn & 1) * 128 + wc * 32 + 8 * fq;
        const int row0 = u.pm * BM + wr * 64 + fr;
        const float* bap = tab + (2 + 2 * dir) * DM; const float* bxp = tab + (3 + 2 * dir) * DM;
        const __amdgpu_buffer_rsrc_t rX = __builtin_amdgcn_make_buffer_rsrc((void*)XC, 0, -1, 0x00020000);
        const __amdgpu_buffer_rsrc_t rR = __builtin_amdgcn_make_buffer_rsrc((void*)(dir ? ws + WS_A0 : dob + DO_D0), 0, -1, 0x00020000);
        const __amdgpu_buffer_rsrc_t rB = __builtin_amdgcn_make_buffer_rsrc((void*)(dir ? ws + WS_A5 : dob + DO_D1), 0, -1, 0x00020000);
        const unsigned vo = (unsigned)(row0 * DM + chb) * 2u;
#pragma unroll
        for (int n = 0; n < 2; ++n) { const int ch0 = chb + 4 * n;
            const f32x4 bav = *(const f32x4*)(bap + ch0), bxv = *(const f32x4*)(bxp + ch0);
#pragma unroll
            for (int ai = 0; ai < 2; ++ai)
#pragma unroll
                for (int m = 0; m < 4; ++m) {
                    const unsigned so = (unsigned)((ai * HALF + m * 16) * DM * 2 + n * 8);
                    const u32x2 xw = __builtin_bit_cast(u32x2, __builtin_amdgcn_raw_buffer_load_b64(rX, vo, so, 0));
                    const f32x4 xv = {bf_lo(xw.x), bf_hi(xw.x), bf_lo(xw.y), bf_hi(xw.y)};
                    const f32x4 za = acc[ai][0][m][n] + bav, zx = acc[ai][1][m][n] + bxv;
                    f32x4 rr, bb;
#pragma unroll
                    for (int i = 0; i < 4; ++i) { rr[i] = sigm(za[i]); bb[i] = sigm(zx[i]) * xv[i]; }
                    u32x2 rw, bw; rw.x = cvt_pk_bf16(rr[0], rr[1]); rw.y = cvt_pk_bf16(rr[2], rr[3]); bw.x = cvt_pk_bf16(bb[0], bb[1]); bw.y = cvt_pk_bf16(bb[2], bb[3]);
                    __builtin_amdgcn_raw_buffer_store_b64(rw, rR, vo, so, 0); __builtin_amdgcn_raw_buffer_store_b64(bw, rB, vo, so, 0);
                    asm volatile("" ::: "memory"); } }
    }
};
template <bool ADD> struct EpiGateMul { static constexpr bool PERM = true;
    const bf16_t* G; bf16_t* T;
    __device__ __forceinline__ void operator()(const Acc& acc, const Unit& u, int wr, int wc, int fr, int fq) const {
        const int row0 = u.pm * BM + wr * 64 + fr, col0 = u.pn * 256 + wc * 32 + 8 * fq;
#pragma unroll
        for (int ai = 0; ai < 2; ++ai)
#pragma unroll
            for (int m = 0; m < 4; ++m) { const size_t ro = (size_t)(row0 + ai * HALF + m * 16) * DM + col0;
#pragma unroll
                for (int bj = 0; bj < 2; ++bj) { const u32x4 gw = *(const u32x4*)(G + ro + bj * HALF);
                    f32x4 g0 = {bf_lo(gw.x), bf_hi(gw.x), bf_lo(gw.y), bf_hi(gw.y)}, g1 = {bf_lo(gw.z), bf_hi(gw.z), bf_lo(gw.w), bf_hi(gw.w)};
                    f32x4 v0 = acc[ai][bj][m][0] * g0, v1 = acc[ai][bj][m][1] * g1;
                    if (ADD) { const u32x4 tw = *(const u32x4*)(T + ro + bj * HALF);
                        v0 += (f32x4){bf_lo(tw.x), bf_hi(tw.x), bf_lo(tw.y), bf_hi(tw.y)}; v1 += (f32x4){bf_lo(tw.z), bf_hi(tw.z), bf_lo(tw.w), bf_hi(tw.w)}; }
                    *(u32x4*)(T + ro + bj * HALF) = pack8(v0, v1); } }
    }
};
template <bool BASE_F32, bool SQ> struct EpiResidBf { static constexpr bool PERM = true;
    const float* xin; bf16_t* XS; float* part;
    __device__ __forceinline__ void operator()(const Acc& acc, const Unit& u, int wr, int wc, int fr, int fq) const {
        const int row0 = u.pm * BM + wr * 64 + fr, col0 = u.pn * 256 + wc * 32 + 8 * fq;
#pragma unroll
        for (int ai = 0; ai < 2; ++ai)
#pragma unroll
            for (int m = 0; m < 4; ++m) { const int row = row0 + ai * HALF + m * 16; const size_t ro = (size_t)row * DM + col0; float sq = 0.f;
#pragma unroll
                for (int bj = 0; bj < 2; ++bj) { f32x4 b0, b1;
                    if (BASE_F32) { b0 = *(const f32x4*)(xin + ro + bj * HALF); b1 = *(const f32x4*)(xin + ro + bj * HALF + 4); }
                    else { const u32x4 w = *(const u32x4*)(XS + ro + bj * HALF); b0 = (f32x4){bf_lo(w.x), bf_hi(w.x), bf_lo(w.y), bf_hi(w.y)}; b1 = (f32x4){bf_lo(w.z), bf_hi(w.z), bf_lo(w.w), bf_hi(w.w)}; }
                    const f32x4 v0 = b0 + acc[ai][bj][m][0], v1 = b1 + acc[ai][bj][m][1];
                    const u32x4 pw = pack8(v0, v1);
                    if (SQ) { const f32x4 r0 = {bf_lo(pw.x), bf_hi(pw.x), bf_lo(pw.y), bf_hi(pw.y)}, r1 = {bf_lo(pw.z), bf_hi(pw.z), bf_lo(pw.w), bf_hi(pw.w)};
                        sq += (r0[0] * r0[0] + r0[1] * r0[1]) + (r0[2] * r0[2] + r0[3] * r0[3]) + (r1[0] * r1[0] + r1[1] * r1[1]) + (r1[2] * r1[2] + r1[3] * r1[3]); }
                    *(u32x4*)(XS + ro + bj * HALF) = pw; }
                if (SQ) { sq += __shfl_xor(sq, 16); sq += __shfl_xor(sq, 32); if (fq == 0) part[(size_t)row * 64 + u.pn * 4 + wc] = sq; } }
    }
};
struct EpiSwiglu { static constexpr bool PERM = true;
    bf16_t* ACT; const float* rowscale;
    __device__ __forceinline__ void operator()(const Acc& acc, const Unit& u, int wr, int wc, int fr, int fq) const {
        const int row0 = u.pm * BM + wr * 64 + fr, col0 = u.pn * 128 + wc * 32 + 8 * fq;
#pragma unroll
        for (int ai = 0; ai < 2; ++ai)
#pragma unroll
            for (int m = 0; m < 4; ++m) { f32x4 v0, v1; const int row = row0 + ai * HALF + m * 16; const float rs = rowscale[row];
#pragma unroll
                for (int i = 0; i < 4; ++i) { v0[i] = silu(acc[ai][0][m][0][i] * rs) * (acc[ai][1][m][0][i] * rs); v1[i] = silu(acc[ai][0][m][1][i] * rs) * (acc[ai][1][m][1][i] * rs); }
                *(u32x4*)(ACT + (size_t)row * DFF + col0) = pack8(v0, v1); }
    }
};

template <class Epi>
__device__ __forceinline__ void gemm_phase(LAS unsigned char* lds, const Gemm g, const StaticOrder& S, const Epi& E, int wave_) {
    const int tid = fresh_tid(wave_), wid = __builtin_amdgcn_readfirstlane(tid >> 6), lane = tid & 63, wr = wid >> 2, wc = wid & 3, fr = lane & 15, fq = lane >> 4;
    const int K = g.K, nt = K / BK;
    unsigned voffA[2], voffB[2];
#pragma unroll
    for (int i = 0; i < 2; ++i) { int R, C; stage_rc(tid * 16 + i * 8192, R, C); const int Rb = Epi::PERM ? ((R & ~31) + perm32(R & 31)) : R;
        voffA[i] = (unsigned)(R * g.lda + C) * 2u; voffB[i] = (unsigned)(Rb * g.ldb + C) * 2u; }
    const unsigned kstep = (unsigned)(BK * 2);
    const unsigned hstepA = (unsigned)HALF * (unsigned)g.lda * 2u, hstepB = (unsigned)HALF * (unsigned)g.ldb * 2u;
    const unsigned ldsw = (unsigned)wid * 1024u;
    const int aoff = lds_byte(wr * 64 + fr, fq * 8), boff = lds_byte(wc * 32 + fr, fq * 8);
    const __amdgpu_buffer_rsrc_t rA = __builtin_amdgcn_make_buffer_rsrc((void*)g.A, 0, -1, 0x00020000), rB = __builtin_amdgcn_make_buffer_rsrc((void*)g.Bt, 0, -1, 0x00020000);
#define PG8_UA(u) ((unsigned)(u).pm * 2u * hstepA + (unsigned)(((u).pn >> g.a_shift) & g.a_mask) * (unsigned)K * 2u)
#define PG8_UB(u) ((unsigned)(u).pn * 2u * hstepB)
#define PG8_SA(b, h) (((b) * 2 + (h)) * HTB)
#define PG8_SB(b, h) ((4 + (b) * 2 + (h)) * HTB)
#define PG8_STAGE(bufoff, rsrc, soff, voff) do { _Pragma("unroll") for (int _i = 0; _i < 2; ++_i) \
        __builtin_amdgcn_raw_ptr_buffer_load_lds(rsrc, (LAS void*)(lds + (bufoff) + ldsw + _i * 8192), 16, (voff)[_i], (soff), 0, 0); } while (0)
#define PG8_LDA(dst, b, h) do { _Pragma("unroll") for (int m = 0; m < 4; ++m) _Pragma("unroll") for (int k = 0; k < 2; ++k) dst[m][k] = *(const LAS bf16x8*)(lds + PG8_SA(b, h) + aoff + m * 2048 + k * 1024); } while (0)
#define PG8_LDB(dst, b, h) do { _Pragma("unroll") for (int n = 0; n < 2; ++n) _Pragma("unroll") for (int k = 0; k < 2; ++k) dst[n][k] = *(const LAS bf16x8*)(lds + PG8_SB(b, h) + boff + n * 2048 + k * 1024); } while (0)
#define PG8_MMA(ai, bj, At, Bt) do { __builtin_amdgcn_s_setprio(1); _Pragma("unroll") for (int m = 0; m < 4; ++m) _Pragma("unroll") for (int n = 0; n < 2; ++n) _Pragma("unroll") for (int k = 0; k < 2; ++k) \
        acc[ai][bj][m][n] = __builtin_amdgcn_mfma_f32_16x16x32_bf16(Bt[n][k], At[m][k], acc[ai][bj][m][n], 0, 0, 0); __builtin_amdgcn_s_setprio(0); } while (0)
#define PG8_WAIT_V(n) asm volatile("s_waitcnt vmcnt(" #n ")" ::: "memory")
#define PG8_WAIT_L(n) asm volatile("s_waitcnt lgkmcnt(" #n ")" ::: "memory")
#define PG8_BAR __builtin_amdgcn_s_barrier()
#define PG8_SCHED __builtin_amdgcn_sched_barrier(0)
    Unit cur, nxt; int ui = 0;
    if (!S.next(0, cur)) return;
    f32x4 acc[2][2][4][2];
#pragma unroll
    for (int a = 0; a < 2; ++a)
#pragma unroll
        for (int b = 0; b < 2; ++b)
#pragma unroll
            for (int m = 0; m < 4; ++m)
#pragma unroll
                for (int n = 0; n < 2; ++n) acc[a][b][m][n] = (f32x4){0.f, 0.f, 0.f, 0.f};
    bf16x8 At[4][2], B0[2][2], B1[2][2];
    unsigned cA = PG8_UA(cur), cB = PG8_UB(cur);
    PG8_STAGE(PG8_SB(0, 0), rB, cB, voffB); PG8_STAGE(PG8_SB(0, 1), rB, cB + hstepB, voffB); PG8_STAGE(PG8_SA(0, 0), rA, cA, voffA); PG8_STAGE(PG8_SA(0, 1), rA, cA + hstepA, voffA);
    if (wr == 1) PG8_BAR;
    PG8_WAIT_V(2); PG8_BAR;
    PG8_STAGE(PG8_SB(1, 0), rB, cB + kstep, voffB); PG8_STAGE(PG8_SA(1, 0), rA, cA + kstep, voffA); PG8_STAGE(PG8_SB(1, 1), rB, cB + hstepB + kstep, voffB);
    PG8_WAIT_V(6); PG8_BAR;
    for (;;) {
        const bool has_next = S.next(ui + 1, nxt);
        const unsigned nA = has_next ? PG8_UA(nxt) : cA, nB = has_next ? PG8_UB(nxt) : cB;
        for (int t = 0; t < nt; t += 2) {
            const bool last = (t == nt - 2);
            const unsigned a1 = cA + (unsigned)(t + 1) * kstep;
            const unsigned a2 = last ? nA : cA + (unsigned)(t + 2) * kstep, b2 = last ? nB : cB + (unsigned)(t + 2) * kstep;
            const unsigned a3 = a2 + kstep, b3 = b2 + kstep;
            PG8_LDB(B0, 0, 0); PG8_LDB(B1, 0, 1); PG8_SCHED; PG8_LDA(At, 0, 0); PG8_STAGE(PG8_SA(1, 1), rA, a1 + hstepA, voffA);
            PG8_WAIT_V(8); PG8_WAIT_L(0); PG8_BAR; PG8_MMA(0, 0, At, B0); PG8_MMA(0, 1, At, B1); PG8_BAR; PG8_SCHED;
            PG8_LDA(At, 0, 1); PG8_STAGE(PG8_SB(0, 0), rB, b2, voffB); PG8_STAGE(PG8_SB(0, 1), rB, b2 + hstepB, voffB); PG8_STAGE(PG8_SA(0, 0), rA, a2, voffA);
            PG8_WAIT_V(8); PG8_WAIT_L(0); PG8_BAR; PG8_MMA(1, 0, At, B0); PG8_MMA(1, 1, At, B1); PG8_BAR; PG8_SCHED;
            PG8_LDB(B0, 1, 0); PG8_LDB(B1, 1, 1); PG8_SCHED; PG8_LDA(At, 1, 0); PG8_STAGE(PG8_SA(0, 1), rA, a2 + hstepA, voffA);
            PG8_WAIT_V(8); PG8_WAIT_L(0); PG8_BAR; PG8_MMA(0, 0, At, B0); PG8_MMA(0, 1, At, B1); PG8_BAR; PG8_SCHED;
            PG8_LDA(At, 1, 1); PG8_STAGE(PG8_SB(1, 0), rB, b3, voffB); PG8_STAGE(PG8_SB(1, 1), rB, b3 + hstepB, voffB); PG8_STAGE(PG8_SA(1, 0), rA, a3, voffA);
            PG8_WAIT_V(8); PG8_WAIT_L(0); PG8_BAR; PG8_MMA(1, 0, At, B0); PG8_MMA(1, 1, At, B1); PG8_BAR; PG8_SCHED;
        }
        if (wr == 0) PG8_BAR;
        PG8_SCHED; E(acc, cur, wr, wc, fr, fq); PG8_SCHED;
        if (!has_next) break;
#pragma unroll
        for (int a = 0; a < 2; ++a)
#pragma unroll
            for (int b = 0; b < 2; ++b)
#pragma unroll
                for (int m = 0; m < 4; ++m)
#pragma unroll
                    for (int n = 0; n < 2; ++n) acc[a][b][m][n] = (f32x4){0.f, 0.f, 0.f, 0.f};
        cur = nxt; cA = nA; cB = nB; ++ui;
        if (wr == 1) PG8_BAR;
    }
    PG8_WAIT_V(0);
    PG8_BAR;
#undef PG8_UA
#undef PG8_UB
#undef PG8_SA
#undef PG8_SB
#undef PG8_STAGE
#undef PG8_LDA
#undef PG8_LDB
#undef PG8_MMA
#undef PG8_WAIT_V
#undef PG8_WAIT_L
#undef PG8_BAR
#undef PG8_SCHED
}
}

namespace att {
constexpr int NW = 8, QBLK = 32, KVBLK = 64;
constexpr int SHM_V = KVBLK * 128 * 2;
#define SBAR() __builtin_amdgcn_sched_barrier(0)
__device__ __forceinline__ int crow(int r, int hi) { return (r & 3) + 8 * (r >> 2) + 4 * hi; }
__device__ __forceinline__ unsigned cvtpk(float lo, float hi) { return cvt_pk_bf16(lo, hi); }
__device__ __forceinline__ bf16x8 ldg8(const bf16_t* p) { return *(const GAS bf16x8*)p; }

template <bool FIRST>
__device__ __forceinline__ void partialSM(f32x16& p0, f32x16& p1, float& m_reg, float& alpha, float thr2) {
    float pmax = p0[0];
#pragma unroll
    for (int r = 1; r < 16; ++r) pmax = fmaxf(pmax, p0[r]);
#pragma unroll
    for (int r = 0; r < 16; ++r) pmax = fmaxf(pmax, p1[r]);
    { auto rr = __builtin_amdgcn_permlane32_swap(__float_as_uint(pmax), __float_as_uint(pmax), false, false);
      pmax = fmaxf(__uint_as_float(rr[0]), __uint_as_float(rr[1])); }
    if (!FIRST && __builtin_expect(__all(pmax <= thr2), 1)) { alpha = 1.f; }
    else { const float d = FIRST ? pmax : fmaxf(pmax, 0.f); alpha = FIRST ? 1.f : __builtin_amdgcn_exp2f(-d); m_reg += d;
#pragma unroll
        for (int r = 0; r < 16; ++r) p0[r] -= d;
#pragma unroll
        for (int r = 0; r < 16; ++r) p1[r] -= d; }
#pragma unroll
    for (int r = 0; r < 16; ++r) p0[r] = __builtin_amdgcn_exp2f(p0[r]);
}
__device__ __forceinline__ void finishSM(f32x16& p0, f32x16& p1, float alpha, float& l_reg, bf16x8& pa0, bf16x8& pa1, bf16x8& pa2, bf16x8& pa3) {
#pragma unroll
    for (int r = 0; r < 16; ++r) p1[r] = __builtin_amdgcn_exp2f(p1[r]);
    float ps = 0;
#pragma unroll
    for (int r = 0; r < 16; ++r) ps += p0[r];
#pragma unroll
    for (int r = 0; r < 16; ++r) ps += p1[r];
    { auto rr = __builtin_amdgcn_permlane32_swap(__float_as_uint(ps), __float_as_uint(ps), false, false);
      ps = __uint_as_float(rr[0]) + __uint_as_float(rr[1]); }
    l_reg = l_reg * alpha + ps;
#define PK4(P, BASE, OUT) do { unsigned a0 = cvtpk(P[BASE + 0], P[BASE + 1]), a1 = cvtpk(P[BASE + 2], P[BASE + 3]);   \
    unsigned b0 = cvtpk(P[BASE + 4], P[BASE + 5]), b1 = cvtpk(P[BASE + 6], P[BASE + 7]);                              \
    auto r0 = __builtin_amdgcn_permlane32_swap(a0, b0, false, false); auto r1 = __builtin_amdgcn_permlane32_swap(a1, b1, false, false); \
    u32x4 w = {r0[0], r1[0], r0[1], r1[1]}; OUT = *reinterpret_cast<bf16x8*>(&w); } while (0)
    PK4(p0, 0, pa0); PK4(p0, 8, pa1); PK4(p1, 0, pa2); PK4(p1, 8, pa3);
#undef PK4
}
__device__ __forceinline__ int v_st(int k, int c) { const int kk = (k & ~0xC) | ((k & 4) << 1) | ((k & 8) >> 1); return ((kk >> 3) * 4 + (c >> 5)) * 512 + ((kk & 7) * 32 + (c & 31)) * 2; }
__device__ __forceinline__ int v_rd_base(int lane) { return ((lane & 3) << 3) | (((lane >> 2) & 3) << 6) | (((lane >> 4) & 1) << 5) | (((lane >> 5) & 1) << 8); }
constexpr int v_rd_off(int d0, int ks, int half) { return d0 * 512 + ks * 4096 + half * 2048; }
template <int OFF> __device__ __forceinline__ s16x4 tr_read(int vb) {
    s16x4 r; asm volatile("ds_read_b64_tr_b16 %0, %1 offset:%2" : "=&v"(r) : "v"(vb), "i"(OFF) : "memory"); return r;
}
template <int D0> __device__ __forceinline__ void pv_one(f32x16& od, int vb, bf16x8 pa0, bf16x8 pa1, bf16x8 pa2, bf16x8 pa3) {
    const s16x4 l0 = tr_read<v_rd_off(D0, 0, 0)>(vb), h0 = tr_read<v_rd_off(D0, 0, 1)>(vb), l1 = tr_read<v_rd_off(D0, 1, 0)>(vb), h1 = tr_read<v_rd_off(D0, 1, 1)>(vb);
    const s16x4 l2 = tr_read<v_rd_off(D0, 2, 0)>(vb), h2 = tr_read<v_rd_off(D0, 2, 1)>(vb), l3 = tr_read<v_rd_off(D0, 3, 0)>(vb), h3 = tr_read<v_rd_off(D0, 3, 1)>(vb);
    asm volatile("s_waitcnt lgkmcnt(0)" ::: "memory"); SBAR();
#define PK(L, H) (bf16x8){L[0], L[1], L[2], L[3], H[0], H[1], H[2], H[3]}
    od = __builtin_amdgcn_mfma_f32_32x32x16_bf16(pa0, PK(l0, h0), od, 0, 0, 0);
    od = __builtin_amdgcn_mfma_f32_32x32x16_bf16(pa1, PK(l1, h1), od, 0, 0, 0);
    od = __builtin_amdgcn_mfma_f32_32x32x16_bf16(pa2, PK(l2, h2), od, 0, 0, 0);
    od = __builtin_amdgcn_mfma_f32_32x32x16_bf16(pa3, PK(l3, h3), od, 0, 0, 0);
#undef PK
}
template <int D0> __device__ __forceinline__ void pv_rd(int vb, s16x4& l0, s16x4& h0, s16x4& l1, s16x4& h1, s16x4& l2, s16x4& h2, s16x4& l3, s16x4& h3) {
    l0 = tr_read<v_rd_off(D0, 0, 0)>(vb); h0 = tr_read<v_rd_off(D0, 0, 1)>(vb); l1 = tr_read<v_rd_off(D0, 1, 0)>(vb); h1 = tr_read<v_rd_off(D0, 1, 1)>(vb);
    l2 = tr_read<v_rd_off(D0, 2, 0)>(vb); h2 = tr_read<v_rd_off(D0, 2, 1)>(vb); l3 = tr_read<v_rd_off(D0, 3, 0)>(vb); h3 = tr_read<v_rd_off(D0, 3, 1)>(vb);
}
#define PVPK(L, H) (bf16x8){L[0], L[1], L[2], L[3], H[0], H[1], H[2], H[3]}
#define PVMMA(od, S) do { od = __builtin_amdgcn_mfma_f32_32x32x16_bf16(pa0, PVPK(S##l0, S##h0), od, 0, 0, 0); od = __builtin_amdgcn_mfma_f32_32x32x16_bf16(pa1, PVPK(S##l1, S##h1), od, 0, 0, 0); \
    od = __builtin_amdgcn_mfma_f32_32x32x16_bf16(pa2, PVPK(S##l2, S##h2), od, 0, 0, 0); od = __builtin_amdgcn_mfma_f32_32x32x16_bf16(pa3, PVPK(S##l3, S##h3), od, 0, 0, 0); } while (0)
__device__ __forceinline__ void pv_d0p(f32x16* o, int vb, bf16x8 pa0, bf16x8 pa1, bf16x8 pa2, bf16x8 pa3) {
    s16x4 Al0, Ah0, Al1, Ah1, Al2, Ah2, Al3, Ah3, Bl0, Bh0, Bl1, Bh1, Bl2, Bh2, Bl3, Bh3;
    pv_rd<0>(vb, Al0, Ah0, Al1, Ah1, Al2, Ah2, Al3, Ah3);
    pv_rd<1>(vb, Bl0, Bh0, Bl1, Bh1, Bl2, Bh2, Bl3, Bh3);
    asm volatile("s_waitcnt lgkmcnt(8)" ::: "memory"); SBAR();
    PVMMA(o[0], A); SBAR();
    pv_rd<2>(vb, Al0, Ah0, Al1, Ah1, Al2, Ah2, Al3, Ah3);
    asm volatile("s_waitcnt lgkmcnt(8)" ::: "memory"); SBAR();
    PVMMA(o[1], B); SBAR();
    pv_rd<3>(vb, Bl0, Bh0, Bl1, Bh1, Bl2, Bh2, Bl3, Bh3);
    asm volatile("s_waitcnt lgkmcnt(8)" ::: "memory"); SBAR();
    PVMMA(o[2], A); SBAR();
    asm volatile("s_waitcnt lgkmcnt(0)" ::: "memory"); SBAR();
    PVMMA(o[3], B);
}
#undef PVMMA
#undef PVPK
__device__ __forceinline__ void pv_d0(f32x16* o, int vb, bf16x8 pa0, bf16x8 pa1, bf16x8 pa2, bf16x8 pa3) {
    pv_one<0>(o[0], vb, pa0, pa1, pa2, pa3); pv_one<1>(o[1], vb, pa0, pa1, pa2, pa3); pv_one<2>(o[2], vb, pa0, pa1, pa2, pa3); pv_one<3>(o[3], vb, pa0, pa1, pa2, pa3);
}

template <int NKA_, int NKB_, int NQREG_, int NQLDS_, int LDQA_, int LDQB_, int LDKA_, int LDKB_, int LDV_, int LDO_, int SEQK_>
struct Cfg { static constexpr int NKA = NKA_, NKB = NKB_, NQREG = NQREG_, NQLDS = NQLDS_, LDQA = LDQA_, LDQB = LDQB_, LDKA = LDKA_, LDKB = LDKB_, LDV = LDV_, LDO = LDO_, SEQK = SEQK_; };
typedef __amdgpu_buffer_rsrc_t rsrc_t;
__device__ __forceinline__ rsrc_t mkrsrc(const void* p) { return __builtin_amdgcn_make_buffer_rsrc((void*)p, 0, -1, 0x00020000); }
__device__ __forceinline__ bf16x8 ldgo(rsrc_t r, unsigned voff, unsigned soff) { return __builtin_bit_cast(bf16x8, __builtin_amdgcn_raw_buffer_load_b128(r, voff, soff, 0)); }
template <class CF>
__device__ __forceinline__ void attn_unit(const bf16_t* QA, const bf16_t* QB, const bf16_t* KA, const bf16_t* KB, const bf16_t* Vh, bf16_t* Ob, float thr_raw, char* lds, int wave_) {
    constexpr int NKA = CF::NKA, NKB = CF::NKB, NQREG = CF::NQREG, NQLDS = CF::NQLDS, NKC = NKA + NKB, SHM_K = NKC * 8192;
    const int tid = fresh_tid(wave_), wid = tid >> 6, lane = tid & 63, r32 = lane & 31, hi = lane >> 5;
    char* V_lds = lds; char* K_lds = lds + 2 * SHM_V;
    float* ws = (float*)(lds + 2 * SHM_V + 2 * SHM_K) + wid * 64; float* li_l = ws; float* al_l = ws + 32;
    float m_reg = 0.f, l_reg = 0; f32x16 o[4];
    { float z_ = 0.f; asm volatile("" : "+v"(z_));
#pragma unroll
      for (int d = 0; d < 4; ++d)
#pragma unroll
          for (int r = 0; r < 16; ++r) o[d][r] = z_; } bf16x8 qr[NQREG ? 4 * NQREG : 1];
    const rsrc_t rQA = mkrsrc(QA), rQB = mkrsrc(QB), rKA = mkrsrc(KA), rKB = mkrsrc(KB), rV = mkrsrc(Vh), rO = mkrsrc(Ob);
    const unsigned qoffA = (unsigned)((wid * QBLK + r32) * CF::LDQA + hi * 8) * 2u, qoffB = (unsigned)((wid * QBLK + r32) * CF::LDQB + hi * 8) * 2u;
    char* q_lds = lds + 2 * SHM_V + 2 * SHM_K + 2048 + wid * (NQLDS ? NQLDS * 4096 : 0) + lane * 16;
    __syncthreads();
#pragma unroll
    for (int c = 0; c < NKC; ++c)
#pragma unroll
        for (int d0 = 0; d0 < 4; ++d0) {
            if (c < NQREG) qr[c * 4 + d0] = (c < NKA) ? ldgo(rQA, qoffA, (c * 64 + d0 * 16) * 2) : ldgo(rQB, qoffB, ((c - NKA) * 64 + d0 * 16) * 2);
            else if (c < NQREG + NQLDS) *(bf16x8*)(q_lds + ((c - NQREG) * 4 + d0) * 1024) = (c < NKA) ? ldgo(rQA, qoffA, (c * 64 + d0 * 16) * 2) : ldgo(rQB, qoffB, ((c - NKA) * 64 + d0 * 16) * 2);
        }
    const int ksw = (r32 >> 1) & 7;
    int koff[4];
#pragma unroll
    for (int d0 = 0; d0 < 4; ++d0) koff[d0] = r32 * 128 + (((d0 * 2 + hi) ^ ksw) << 4);
    const int krow = tid >> 3, kp = tid & 7, kst = krow * 128 + ((kp ^ ((krow >> 1) & 7)) << 4);
    const int sr = tid >> 4, sc = (tid & 15) * 8, vst0 = v_st(sr, sc), vst1 = v_st(32 + sr, sc);
    const unsigned kgA = (unsigned)(krow * CF::LDKA + kp * 8) * 2u, kgB = (unsigned)(krow * CF::LDKB + kp * 8) * 2u, vg = (unsigned)(sr * CF::LDV + sc) * 2u;
    const int vb0 = (int)(uintptr_t)V_lds + v_rd_base(lane);
    bf16x8 s_vs0, s_vs1, s_ks[NKC];
#define SLOAD(k0) do { const unsigned vt_ = (unsigned)(k0) * (CF::LDV * 2u), ka_ = (unsigned)(k0) * (CF::LDKA * 2u), kb_ = (unsigned)(k0) * (CF::LDKB * 2u); \
    s_vs0 = ldgo(rV, vg, vt_); s_vs1 = ldgo(rV, vg, vt_ + 32u * CF::LDV * 2u); \
    _Pragma("unroll") for (int c = 0; c < NKC; ++c) s_ks[c] = (c < NKA) ? ldgo(rKA, kgA, ka_ + c * 128) : ldgo(rKB, kgB, kb_ + (c - NKA) * 128); } while (0)
#define SWRITE(b) do { *(bf16x8*)(V_lds + (b) * SHM_V + vst0) = s_vs0; *(bf16x8*)(V_lds + (b) * SHM_V + vst1) = s_vs1; \
    _Pragma("unroll") for (int c = 0; c < NKC; ++c) *(bf16x8*)(K_lds + (b) * SHM_K + c * 8192 + kst) = s_ks[c]; } while (0)
#define SWAIT() asm volatile("s_waitcnt vmcnt(0)" ::: "memory")
#define RESC(a) do { if (__any((a) < 1.f)) { if (hi == 0) al_l[r32] = (a); asm volatile("s_waitcnt lgkmcnt(0)" ::: "memory"); \
    _Pragma("unroll") for (int d = 0; d < 4; ++d) _Pragma("unroll") for (int r = 0; r < 16; ++r) o[d][r] *= al_l[crow(r, hi)]; } } while (0)
#define QKT(P0, P1, KB_) QKT_(P0, P1, KB_, false)
#define QKT_(P0, P1, KB_, ZERO_) do { __builtin_amdgcn_iglp_opt(0); if (ZERO_) { P0 = f32x16{}; P1 = f32x16{}; } else { const float nm_ = -m_reg; _Pragma("unroll") for (int r_ = 0; r_ < 16; ++r_) { P0[r_] = nm_; P1[r_] = nm_; } } const char* kt_ = K_lds + (KB_) * SHM_K; \
    _Pragma("unroll") for (int c = 0; c < NKC; ++c) _Pragma("unroll") for (int d0 = 0; d0 < 4; ++d0) { \
        const bf16x8 b0 = *(const bf16x8*)(kt_ + c * 8192 + koff[d0]); const bf16x8 b1 = *(const bf16x8*)(kt_ + c * 8192 + 4096 + koff[d0]); \
        bf16x8 qf; if (c < NQREG) qf = qr[(c < NQREG ? c : 0) * 4 + d0]; else if (c < NQREG + NQLDS) qf = *(const bf16x8*)(q_lds + ((c - NQREG) * 4 + d0) * 1024); \
        else qf = (c < NKA) ? ldgo(rQA, qoffA, (c * 64 + d0 * 16) * 2) : ldgo(rQB, qoffB, ((c - NKA) * 64 + d0 * 16) * 2); \
        P0 = __builtin_amdgcn_mfma_f32_32x32x16_bf16(b0, qf, P0, 0, 0, 0); P1 = __builtin_amdgcn_mfma_f32_32x32x16_bf16(b1, qf, P1, 0, 0, 0); } } while (0)
    f32x16 pA0, pA1, pB0, pB1; float alA, alB; bf16x8 pa0, pa1, pa2, pa3; constexpr int NT = CF::SEQK / KVBLK;
    SLOAD(0); SWAIT(); SWRITE(0); __syncthreads();
    QKT_(pA0, pA1, 0, true); partialSM<true>(pA0, pA1, m_reg, alA, thr_raw);
    SLOAD(KVBLK);
    SWAIT(); SWRITE(1); __syncthreads();
    for (int j = 1; j + 1 < NT; j += 2) {
        SBAR(); QKT(pB0, pB1, 1);
        finishSM(pA0, pA1, alA, l_reg, pa0, pa1, pa2, pa3); SBAR();
        SLOAD((j + 1) * KVBLK); SBAR();
        pv_d0(o, vb0, pa0, pa1, pa2, pa3); partialSM<false>(pB0, pB1, m_reg, alB, thr_raw);
        __syncthreads(); SWAIT(); SWRITE(0);
        RESC(alB); __syncthreads();
        SBAR(); QKT(pA0, pA1, 0);
        finishSM(pB0, pB1, alB, l_reg, pa0, pa1, pa2, pa3); SBAR();
        SLOAD((j + 2) * KVBLK); SBAR();
        pv_d0(o, vb0 + SHM_V, pa0, pa1, pa2, pa3); partialSM<false>(pA0, pA1, m_reg, alA, thr_raw);
        __syncthreads(); SWAIT(); SWRITE(1);
        RESC(alA); __syncthreads();
    }
    SBAR(); QKT(pB0, pB1, 1);
    finishSM(pA0, pA1, alA, l_reg, pa0, pa1, pa2, pa3); SBAR();
    pv_d0(o, vb0, pa0, pa1, pa2, pa3); partialSM<false>(pB0, pB1, m_reg, alB, thr_raw);
    __syncthreads(); RESC(alB);
    finishSM(pB0, pB1, alB, l_reg, pa0, pa1, pa2, pa3); SBAR();
    pv_d0(o, vb0 + SHM_V, pa0, pa1, pa2, pa3);
    if (hi == 0) li_l[r32] = l_reg; asm volatile("s_waitcnt lgkmcnt(0)" ::: "memory");
    float rli[16];
#pragma unroll
    for (int r = 0; r < 16; ++r) rli[r] = __builtin_amdgcn_rcpf(li_l[crow(r, hi)]);
    const unsigned ob = (unsigned)((wid * QBLK + 4 * hi) * CF::LDO + r32) * 2u;
#pragma unroll
    for (int r = 0; r < 16; ++r) {
#pragma unroll
        for (int d0 = 0; d0 < 4; ++d0) __builtin_amdgcn_raw_buffer_store_b16((short)f2bf(o[d0][r] * rli[r]), rO, ob, (unsigned)((((r & 3) + 8 * (r >> 2)) * CF::LDO + d0 * 32) * 2), 0); }
#undef SLOAD
#undef SWRITE
#undef SWAIT
#undef RESC
#undef QKT
#undef QKT_
}
template <class CF>
__device__ __forceinline__ void attn_unit_dma(const bf16_t* QA, const bf16_t* QB, const bf16_t* KA, const bf16_t* KB, const bf16_t* Vh, bf16_t* Ob, float thr_raw, char* lds, LAS unsigned char* ldsl, int wave_) {
    constexpr int NKA = CF::NKA, NKB = CF::NKB, NQREG = CF::NQREG, NKC = NKA + NKB, SHM_K = NKC * 8192;
    static_assert(CF::NQLDS == 0 && NQREG == NKC, "all Q chunks in registers");
    const int tid = fresh_tid(wave_), wid = tid >> 6, lane = tid & 63, r32 = lane & 31, hi = lane >> 5;
    char* V_lds = lds; char* K_lds = lds + 2 * SHM_V;
    float* ws = (float*)(lds + 2 * SHM_V + 2 * SHM_K) + wid * 64; float* li_l = ws; float* al_l = ws + 32;
    float m_reg = 0.f, l_reg = 0; f32x16 o[4];
    { float z_ = 0.f; asm volatile("" : "+v"(z_));
#pragma unroll
      for (int d = 0; d < 4; ++d)
#pragma unroll
          for (int r = 0; r < 16; ++r) o[d][r] = z_; } bf16x8 qr[4 * NQREG];
    const rsrc_t rQA = mkrsrc(QA), rQB = mkrsrc(QB), rKA = mkrsrc(KA), rKB = mkrsrc(KB), rV = mkrsrc(Vh), rO = mkrsrc(Ob);
    const unsigned qoffA = (unsigned)((wid * QBLK + r32) * CF::LDQA + hi * 8) * 2u, qoffB = (unsigned)((wid * QBLK + r32) * CF::LDQB + hi * 8) * 2u;
    __syncthreads();
    const int kr_ = 8 * wave_ + (lane >> 3), kp_ = (lane & 7) ^ ((kr_ >> 1) & 7);
    const unsigned kdA = (unsigned)(kr_ * CF::LDKA) * 2u + (unsigned)kp_ * 16u, kdB = (unsigned)(kr_ * CF::LDKB) * 2u + (unsigned)kp_ * 16u;
    unsigned vd[2];
    { const int kk = 8 * wave_ + ((lane >> 2) & 7), k = (kk & ~0xC) | ((kk & 4) << 1) | ((kk & 8) >> 1);
#pragma unroll
      for (int i = 0; i < 2; ++i) vd[i] = (unsigned)(k * CF::LDV + (2 * i + (lane >> 5)) * 32 + (lane & 3) * 8) * 2u; }
#define KPIECE(b, k0, c) do { if ((c) < NKA) __builtin_amdgcn_raw_ptr_buffer_load_lds(rKA, (LAS void*)(ldsl + 2 * SHM_V + (b) * SHM_K + (c) * 8192 + wave_ * 1024), 16, kdA, (unsigned)(k0) * (CF::LDKA * 2u) + (c) * 128, 0, 0); \
        else __builtin_amdgcn_raw_ptr_buffer_load_lds(rKB, (LAS void*)(ldsl + 2 * SHM_V + (b) * SHM_K + (c) * 8192 + wave_ * 1024), 16, kdB, (unsigned)(k0) * (CF::LDKB * 2u) + ((c) - NKA) * 128, 0, 0); } while (0)
#define VPIECE(b, k0, i) __builtin_amdgcn_raw_ptr_buffer_load_lds(rV, (LAS void*)(ldsl + (b) * SHM_V + (2 * wave_ + (i)) * 1024), 16, vd[i], (unsigned)(k0) * (CF::LDV * 2u), 0, 0)
#define KDMA(b, k0) do { _Pragma("unroll") for (int c = 0; c < NKC; ++c) KPIECE(b, k0, c); } while (0)
#define VDMA(b, k0) do { _Pragma("unroll") for (int i = 0; i < 2; ++i) VPIECE(b, k0, i); } while (0)
#define BARD() do { asm volatile("s_waitcnt vmcnt(0) lgkmcnt(0)" ::: "memory"); __builtin_amdgcn_s_barrier(); asm volatile("" ::: "memory"); } while (0)
    KDMA(0, 0); VDMA(0, 0); KDMA(1, KVBLK);
#pragma unroll
    for (int c = 0; c < NKC; ++c)
#pragma unroll
        for (int d0 = 0; d0 < 4; ++d0) qr[c * 4 + d0] = (c < NKA) ? ldgo(rQA, qoffA, (c * 64 + d0 * 16) * 2) : ldgo(rQB, qoffB, ((c - NKA) * 64 + d0 * 16) * 2);
    const int ksw = (r32 >> 1) & 7;
    int koff[4];
#pragma unroll
    for (int d0 = 0; d0 < 4; ++d0) koff[d0] = r32 * 128 + (((d0 * 2 + hi) ^ ksw) << 4);
    const int vb0 = (int)(uintptr_t)V_lds + v_rd_base(lane);
#define RESC(a) do { if (__any((a) < 1.f)) { if (hi == 0) al_l[r32] = (a); asm volatile("s_waitcnt lgkmcnt(0)" ::: "memory"); \
    _Pragma("unroll") for (int d = 0; d < 4; ++d) _Pragma("unroll") for (int r = 0; r < 16; ++r) o[d][r] *= al_l[crow(r, hi)]; } } while (0)
#define QKT_(P0, P1, KB_, ZERO_, DOK_, KD_, KK0_, DOV_, VD_, VK0_) do { __builtin_amdgcn_iglp_opt(0); if (ZERO_) { P0 = f32x16{}; P1 = f32x16{}; } else { const float nm_ = -m_reg; _Pragma("unroll") for (int r_ = 0; r_ < 16; ++r_) { P0[r_] = nm_; P1[r_] = nm_; } } const char* kt_ = K_lds + (KB_) * SHM_K; \
    _Pragma("unroll") for (int c = 0; c < NKC; ++c) _Pragma("unroll") for (int d0 = 0; d0 < 4; ++d0) { \
        const bf16x8 b0 = *(const bf16x8*)(kt_ + c * 8192 + koff[d0]); const bf16x8 b1 = *(const bf16x8*)(kt_ + c * 8192 + 4096 + koff[d0]); \
        const bf16x8 qf = qr[c * 4 + d0]; \
        P0 = __builtin_amdgcn_mfma_f32_32x32x16_bf16(b0, qf, P0, 0, 0, 0); P1 = __builtin_amdgcn_mfma_f32_32x32x16_bf16(b1, qf, P1, 0, 0, 0); \
        { const int t_ = 4 * c + d0; if (DOK_) { if (t_ == 1) KPIECE(KD_, KK0_, 0); if (t_ == 3) KPIECE(KD_, KK0_, 1); if (t_ == 5) KPIECE(KD_, KK0_, 2); } \
          if (DOV_) { if (t_ == 7) VPIECE(VD_, VK0_, 0); if (t_ == 9) VPIECE(VD_, VK0_, 1); } } } } while (0)
    f32x16 pA0, pA1, pB0, pB1; float alA, alB; bf16x8 pa0, pa1, pa2, pa3; constexpr int NT = CF::SEQK / KVBLK;
    static_assert(NT % 2 == 0 && NT >= 4, "tile count");
    BARD();
    QKT_(pA0, pA1, 0, true, false, 0, 0, false, 0, 0); partialSM<true>(pA0, pA1, m_reg, alA, thr_raw);
    for (int j = 0; j + 2 < NT; j += 2) {
        BARD(); SBAR();
        QKT_(pB0, pB1, 1, false, true, 0, (j + 2) * KVBLK, true, 1, (j + 1) * KVBLK);
        finishSM(pA0, pA1, alA, l_reg, pa0, pa1, pa2, pa3); SBAR();
        pv_d0p(o, vb0, pa0, pa1, pa2, pa3); partialSM<false>(pB0, pB1, m_reg, alB, thr_raw);
        RESC(alB);
        BARD(); SBAR();
        QKT_(pA0, pA1, 0, false, true, 1, (j + 3) * KVBLK, true, 0, (j + 2) * KVBLK);
        finishSM(pB0, pB1, alB, l_reg, pa0, pa1, pa2, pa3); SBAR();
        pv_d0p(o, vb0 + SHM_V, pa0, pa1, pa2, pa3); partialSM<false>(pA0, pA1, m_reg, alA, thr_raw);
        RESC(alA);
    }
    BARD(); SBAR();
    QKT_(pB0, pB1, 1, false, false, 0, 0, true, 1, (NT - 1) * KVBLK);
    finishSM(pA0, pA1, alA, l_reg, pa0, pa1, pa2, pa3); SBAR();
    pv_d0p(o, vb0, pa0, pa1, pa2, pa3); partialSM<false>(pB0, pB1, m_reg, alB, thr_raw);
    RESC(alB);
    BARD(); SBAR();
    finishSM(pB0, pB1, alB, l_reg, pa0, pa1, pa2, pa3); SBAR();
    pv_d0p(o, vb0 + SHM_V, pa0, pa1, pa2, pa3);
    if (hi == 0) li_l[r32] = l_reg; asm volatile("s_waitcnt lgkmcnt(0)" ::: "memory");
    float rli[16];
#pragma unroll
    for (int r = 0; r < 16; ++r) rli[r] = __builtin_amdgcn_rcpf(li_l[crow(r, hi)]);
    const unsigned ob = (unsigned)((wid * QBLK + 4 * hi) * CF::LDO + r32) * 2u;
#pragma unroll
    for (int r = 0; r < 16; ++r) {
#pragma unroll
        for (int d0 = 0; d0 < 4; ++d0) __builtin_amdgcn_raw_buffer_store_b16((short)f2bf(o[d0][r] * rli[r]), rO, ob, (unsigned)((((r & 3) + 8 * (r >> 2)) * CF::LDO + d0 * 32) * 2), 0); }
#undef KPIECE
#undef VPIECE
#undef KDMA
#undef VDMA
#undef BARD
#undef RESC
#undef QKT_
}
}

#define XB_TMO      128
#define XB_XCNT(j)  (256  + 64 * (j))
#define XB_XSUB(j)  (1280 + 64 * (j))
#define XB_XGEN(j)  (2304 + 64 * (j))
#define XB_TOP      3328
#define XB_TOPGEN   3392
#define XCD_BAR_WORDS 3456
#define XB_SPIN_CAP (1u << 20)
__device__ __forceinline__ unsigned xb_ld(unsigned* p)              { return __hip_atomic_load(p, __ATOMIC_RELAXED, __HIP_MEMORY_SCOPE_AGENT); }
__device__ __forceinline__ unsigned xb_add(unsigned* p, unsigned v) { return __hip_atomic_fetch_add(p, v, __ATOMIC_RELAXED, __HIP_MEMORY_SCOPE_AGENT); }
__device__ __forceinline__ unsigned xb_xcc_id() { return (unsigned)__builtin_amdgcn_s_getreg((3 << 11) | 20) & 0xFu; }
#define XB_SPIN(cond, bar) do { unsigned _sp = 0; while (cond) { __builtin_amdgcn_s_sleep(1); \
    if ((++_sp & 255u) == 0u) { if (xb_ld(&(bar)[XB_TMO])) break; if (_sp > XB_SPIN_CAP) { atomicAdd(&(bar)[XB_TMO], 1u); break; } } } } while (0)
struct XcdBarrier { unsigned* bar; unsigned x; volatile LAS unsigned* st; };
__device__ __forceinline__ XcdBarrier xcd_barrier_post(unsigned* bar, volatile LAS unsigned* st, int wave_) {
    XcdBarrier b; b.bar = bar; b.x = xb_xcc_id(); b.st = st;
    if (wave_ == 0 && lane_id() == 0) (void)xb_add(&bar[XB_XCNT(b.x)], 1u);
    return b;
}
__device__ __forceinline__ void xcd_barrier_complete(unsigned* bar, unsigned x, unsigned& nloc, unsigned& nx) {
    const unsigned G = gridDim.x * gridDim.y * gridDim.z;
    unsigned sum, cnt, mine, sp = 0u;
    for (;;) {
        sum = 0u; cnt = 0u; mine = 0u;
#pragma unroll
        for (unsigned j = 0; j < 16; ++j) { const unsigned c = xb_ld(&bar[XB_XCNT(j)]); sum += c; cnt += (c > 0u) ? 1u : 0u; mine = (j == x) ? c : mine; }
        if (sum == G) break;
        __builtin_amdgcn_s_sleep(1);
        if ((++sp & 255u) == 0u) { if (xb_ld(&bar[XB_TMO])) break; if (sp > XB_SPIN_CAP) { atomicAdd(&bar[XB_TMO], 1u); break; } }
    }
    nloc = mine > 0u ? mine : 1u; nx = cnt > 0u ? cnt : 1u;
}
__device__ __forceinline__ void xcd_barrier(const XcdBarrier& b, int wave_) {
    asm volatile("s_waitcnt vmcnt(0)" ::: "memory");
    __syncthreads();
    if (wave_ == 0 && lane_id() == 0) {
        unsigned* bar = b.bar;
        __builtin_amdgcn_s_waitcnt(0);
        unsigned nloc = b.st[0], nx = b.st[1];
        if (nloc == 0u) { xcd_barrier_complete(bar, b.x, nloc, nx); b.st[0] = nloc; b.st[1] = nx; }
        const unsigned old = xb_add(&bar[XB_XSUB(b.x)], 1u);
        const unsigned gen = old / nloc;
        if (old + 1u == (gen + 1u) * nloc) {
            __builtin_amdgcn_fence(__ATOMIC_RELEASE, "agent");
            asm volatile("s_waitcnt vmcnt(0)" ::: "memory");
            const unsigned og = xb_add(&bar[XB_TOP], 1u);
            const unsigned tg = og / nx;
            if (og + 1u == (tg + 1u) * nx) xb_add(&bar[XB_TOPGEN], 1u);
            else XB_SPIN(xb_ld(&bar[XB_TOPGEN]) == tg, bar);
            __builtin_amdgcn_fence(__ATOMIC_ACQUIRE, "agent");
            xb_add(&bar[XB_XGEN(b.x)], 1u);
            asm volatile("s_waitcnt vmcnt(0)" ::: "memory");
        } else {
            XB_SPIN(xb_ld(&bar[XB_XGEN(b.x)]) == gen, bar);
            __builtin_amdgcn_fence(__ATOMIC_ACQUIRE, "agent");
            asm volatile("s_waitcnt vmcnt(0)" ::: "memory");
        }
    }
    __syncthreads();
}

struct Args { const void* in[34]; float* out; unsigned char* ws; int ph_lo, ph_hi; };

struct Frame {
    LAS unsigned char* lds; int wave, vcu, G;
};
#define FTID (F.wave * 64 + lane_id())
#define FLANE lane_id()

enum { MAP_ID = 0, MAP_IN, MAP_UQ, MAP_UKV, MAP_MKV, MAP_FG, MAP_FU };
__device__ __forceinline__ int dest_row(int map, int c) {
    switch (map) {
    case MAP_IN:  return c < 8192 ? c : c < 9216 ? 16384 + (c - 8192) : c < 9728 ? 17408 + (c - 9216) : c < 9792 ? 17920 + (c - 9728) : c < 13888 ? 8192 + (c - 9792) : 12288 + (c - 13888);
    case MAP_UQ:  { const int head = c / 192, d = c - head * 192; return d < 128 ? head * 128 + d : 4096 + head * 64 + 2 * ((d - 128) & 31) + ((d - 128) >> 5); }
    case MAP_UKV: { const int head = c >> 8, d = c & 255; return d < 128 ? head * 128 + d : 4096 + head * 128 + (d - 128); }
    case MAP_MKV: { const int head = c >> 9, e = c & 511; return e < 256 ? head * 256 + e : 1024 + head * 256 + (e - 256); }
    case MAP_FG:  return (c >> 7) * 256 + (c & 127);
    case MAP_FU:  return (c >> 7) * 256 + 128 + (c & 127);
    default:      return c;
    }
}
__device__ __forceinline__ void cvt_item64(const float* src, int ld, int K, int nblk, bf16_t* dst, int map, int row_add, const float* kscale, LAS unsigned* tile, int item, int lane) {
    const int kb = item / nblk, nb = item - kb * nblk, k0 = 64 * kb, c0 = 64 * nb, q = lane & 15, kr = lane >> 4;
    const GAS float* sp = (const GAS float*)src + (size_t)(k0 + 2 * kr) * ld + c0 + 4 * q;
    f32x4 v[8][2];
#pragma unroll
    for (int m = 0; m < 8; ++m)
#pragma unroll
        for (int e = 0; e < 2; ++e) v[m][e] = __builtin_nontemporal_load((const GAS f32x4*)(sp + (size_t)(8 * m + e) * ld));
    if (kscale) {
#pragma unroll
        for (int m = 0; m < 8; ++m)
#pragma unroll
            for (int e = 0; e < 2; ++e) v[m][e] = v[m][e] * kscale[k0 + 8 * m + 2 * kr + e];
    }
#pragma unroll
    for (int m = 0; m < 8; ++m)
#pragma unroll
        for (int i = 0; i < 4; ++i) tile[(4 * q + i) * 33 + 4 * m + kr] = cvt_pk_bf16(v[m][0][i], v[m][1][i]);
    LDS_WAIT(); asm volatile("" ::: "memory");
    const int c = lane & 7;
    const int dbase = dest_row(map, c0) + row_add; const bool rope = (map == MAP_UQ) && (c0 % 192 == 128);
#pragma unroll
    for (int j = 0; j < 8; ++j) { const int n = (lane >> 3) + 8 * j; const LAS unsigned* tp = tile + n * 33 + 4 * c;
        u32x4 o; o.x = tp[0]; o.y = tp[1]; o.z = tp[2]; o.w = tp[3];
        *(GAS u32x4*)(dst + (size_t)(dbase + (rope ? 2 * (n & 31) + (n >> 5) : n)) * K + k0 + 8 * c) = o; }
    LDS_WAIT(); asm volatile("" ::: "memory");
}

template <bool OUTF>
__device__ __forceinline__ void rms_rows(const Frame& F, const float* src, const float* g, void* dst, int rows) {
    const int gw = F.vcu * NWAVES + F.wave, NGW = F.G * NWAVES, lane = FLANE;
    int m = gw; if (m >= rows) return;
    f32x4 gv[16], v[16], vn[16];
#pragma unroll
    for (int j = 0; j < 16; ++j) gv[j] = ((const GAS f32x4*)g)[64 * j + lane];
#pragma unroll
    for (int j = 0; j < 16; ++j) v[j] = ((const GAS f32x4*)(src + (size_t)m * DM))[64 * j + lane];
    for (;;) {
        const int mn = m + NGW; const bool hn = mn < rows;
        if (hn) {
#pragma unroll
            for (int j = 0; j < 16; ++j) vn[j] = ((const GAS f32x4*)(src + (size_t)mn * DM))[64 * j + lane]; }
        asm volatile("" ::: "memory");
        float s = 0.f;
#pragma unroll
        for (int j = 0; j < 16; ++j) s += (v[j].x * v[j].x + v[j].y * v[j].y) + (v[j].z * v[j].z + v[j].w * v[j].w);
        const float inv = __builtin_amdgcn_rsqf(wave_sum(s) * (1.f / DM) + EPS);
        if constexpr (OUTF) { GAS f32x4* o = (GAS f32x4*)((float*)dst + (size_t)m * DM) + lane;
#pragma unroll
            for (int j = 0; j < 16; ++j) o[64 * j] = v[j] * inv * gv[j];
        } else { GAS u32x2* o = (GAS u32x2*)((bf16_t*)dst + (size_t)m * DM) + lane;
#pragma unroll
            for (int j = 0; j < 16; ++j) { const f32x4 t = v[j] * inv * gv[j]; u32x2 w; w.x = cvt_pk_bf16(t.x, t.y); w.y = cvt_pk_bf16(t.z, t.w); o[64 * j] = w; } }
        if (!hn) break;
#pragma unroll
        for (int j = 0; j < 16; ++j) v[j] = vn[j];
        m = mn;
    }
}

__device__ __forceinline__ void rms_rows_bf(const Frame& F, const bf16_t* src, const float* g, float* dst, int rows) {
    const int gw = F.vcu * NWAVES + F.wave, NGW = F.G * NWAVES, lane = FLANE;
    int m = gw; if (m >= rows) return;
    f32x4 gv[16]; u32x4 v[8], vn[8];
#pragma unroll
    for (int j = 0; j < 8; ++j) { gv[2 * j] = ((const GAS f32x4*)g)[2 * (64 * j + lane)]; gv[2 * j + 1] = ((const GAS f32x4*)g)[2 * (64 * j + lane) + 1]; }
#pragma unroll
    for (int j = 0; j < 8; ++j) v[j] = ((const GAS u32x4*)(src + (size_t)m * DM))[64 * j + lane];
    for (;;) {
        const int mn = m + NGW; const bool hn = mn < rows;
        if (hn) {
#pragma unroll
            for (int j = 0; j < 8; ++j) vn[j] = ((const GAS u32x4*)(src + (size_t)mn * DM))[64 * j + lane]; }
        asm volatile("" ::: "memory");
        float s = 0.f; f32x4 f[16];
#pragma unroll
        for (int j = 0; j < 8; ++j) { f[2 * j] = (f32x4){bf_lo(v[j].x), bf_hi(v[j].x), bf_lo(v[j].y), bf_hi(v[j].y)}; f[2 * j + 1] = (f32x4){bf_lo(v[j].z), bf_hi(v[j].z), bf_lo(v[j].w), bf_hi(v[j].w)}; }
#pragma unroll
        for (int j = 0; j < 16; ++j) s += (f[j].x * f[j].x + f[j].y * f[j].y) + (f[j].z * f[j].z + f[j].w * f[j].w);
        const float inv = __builtin_amdgcn_rsqf(wave_sum(s) * (1.f / DM) + EPS);
        GAS f32x4* o = (GAS f32x4*)(dst + (size_t)m * DM);
#pragma unroll
        for (int j = 0; j < 8; ++j) { __builtin_nontemporal_store(f[2 * j] * inv * gv[2 * j], &o[2 * (64 * j + lane)]); __builtin_nontemporal_store(f[2 * j + 1] * inv * gv[2 * j + 1], &o[2 * (64 * j + lane) + 1]); }
        if (!hn) break;
#pragma unroll
        for (int j = 0; j < 8; ++j) v[j] = vn[j];
        m = mn;
    }
}
__device__ __forceinline__ void inv_rows(const Frame& F, const float* part, float* inv, float cmul) {
    for (int row = blockIdx.x * (NWAVES * 64) + FTID; row < M; row += F.G * NWAVES * 64) { const GAS f32x4* p = (const GAS f32x4*)(part + (size_t)row * 64); float s = 0.f;
#pragma unroll
        for (int j = 0; j < 16; ++j) { const f32x4 t = p[j]; s += (t.x + t.y) + (t.z + t.w); }
        inv[row] = cmul * __builtin_amdgcn_rsqf(s * (1.f / DM) + EPS); }
}

constexpr int NDEF = 3 * 11008 + 3 * 4096 + 2 * 1024;
__device__ __forceinline__ void cvt_deferred(const Args& a, unsigned char* ws, int it, LAS unsigned* tile, int lane) {
    if (it < 11008)      cvt_item64((const float*)a.in[30], DFF, DM, DFF / 64, (bf16_t*)(ws + WS_WGU), MAP_FG, 0, (const float*)a.in[29], tile, it, lane);
    else if (it < 22016) cvt_item64((const float*)a.in[31], DFF, DM, DFF / 64, (bf16_t*)(ws + WS_WGU), MAP_FU, 0, (const float*)a.in[29], tile, it - 11008, lane);
    else if (it < 33024) cvt_item64((const float*)a.in[32], DM, DFF, DM / 64, (bf16_t*)(ws + WS_WD), MAP_ID, 0, nullptr, tile, it - 22016, lane);
    else if (it < 37120) cvt_item64((const float*)a.in[21], DM, DM, DM / 64, (bf16_t*)(ws + WS_WPL), MAP_ID, 0, nullptr, tile, it - 33024, lane);
    else if (it < 41216) cvt_item64((const float*)a.in[22], DM, DM, DM / 64, (bf16_t*)(ws + WS_WPM), MAP_ID, 0, nullptr, tile, it - 37120, lane);
    else if (it < 45312) cvt_item64((const float*)a.in[23], DM, DM, DM / 64, (bf16_t*)(ws + WS_WO), MAP_ID, 0, nullptr, tile, it - 41216, lane);
    else if (it < 46336) cvt_item64((const float*)a.in[26], 1024, DM, 1024 / 64, (bf16_t*)(ws + WS_WMQ), MAP_ID, 0, (const float*)a.in[24], tile, it - 45312, lane);
    else                 cvt_item64((const float*)a.in[28], DM, 1024, DM / 64, (bf16_t*)(ws + WS_WMO), MAP_ID, 0, nullptr, tile, it - 46336, lane);
}

__global__ void __launch_bounds__(NWAVES * 64, 2) mk_fwd(Args args) {
    extern __shared__ __attribute__((aligned(16))) unsigned char lds[];
    Frame F;
    F.lds = (LAS unsigned char*)lds;
    constexpr int SWI_UNITS = (M / 256) * (2 * DFF / 256); const bool TAILCVT = (SWI_UNITS % (int)gridDim.x) != 0;
    volatile LAS unsigned* MISC = (volatile LAS unsigned*)(F.lds + MISC_OFF);
    F.wave = __builtin_amdgcn_readfirstlane((int)threadIdx.x >> 6);
    F.G = gridDim.x; { const int bx = blockIdx.x; F.vcu = (F.G % 8 == 0) ? (bx % 8) * (F.G / 8) + bx / 8 : bx; }
    unsigned char* ws = args.ws; unsigned char* dob = (unsigned char*)args.out;
    unsigned* ctl = (unsigned*)(ws + WS_CTL);
    for (int u = FTID; u < (LDS_BYTES - LDSCTL_OFF) / 4; u += NWAVES * 64) ((LAS unsigned*)(F.lds + LDSCTL_OFF))[u] = 0u;
    __syncthreads();
#if MK_PER_PHASE
    XcdBarrier bar; bar.bar = ctl + CW_BAR; bar.x = 0; bar.st = nullptr;
#define GRID_BAR() do { } while (0)
#else
    XcdBarrier bar = xcd_barrier_post(ctl + CW_BAR, MISC + 8, F.wave);
#define GRID_BAR() xcd_barrier(bar, F.wave)
#endif
    const int lo = args.ph_lo, hi = args.ph_hi;
#define IN(k) (lo <= (k) && (k) < hi)
#define SEAM(k) do { if (IN(k) && IN((k) + 1)) GRID_BAR(); } while (0)
    const int gw = F.vcu * NWAVES + F.wave, NGW = F.G * NWAVES;

    const float* x = (const float*)args.in[0];
    float* CS = (float*)(ws + WS_CS); bf16_t* HM = (bf16_t*)(ws + WS_HM); bf16_t* MK = (bf16_t*)(ws + WS_MK); bf16_t* MV = (bf16_t*)(ws + WS_MV);
    float* INVQ = (float*)(ws + WS_INVQ); float* INVKV = (float*)(ws + WS_INVKV); float* C2 = (float*)(ws + WS_C2); float* AGG = (float*)(ws + WS_AGG);
    bf16_t* WIN = (bf16_t*)(ws + WS_WIN); bf16_t* WG = (bf16_t*)(ws + WS_WG); bf16_t* WUQ = (bf16_t*)(ws + WS_WUQ); bf16_t* WUKV = (bf16_t*)(ws + WS_WUKV);
    bf16_t* WPL = (bf16_t*)(ws + WS_WPL); bf16_t* WPM = (bf16_t*)(ws + WS_WPM); bf16_t* WO = (bf16_t*)(ws + WS_WO); bf16_t* WMQ = (bf16_t*)(ws + WS_WMQ);
    bf16_t* WMKV = (bf16_t*)(ws + WS_WMKV); bf16_t* WMO = (bf16_t*)(ws + WS_WMO); bf16_t* WGU = (bf16_t*)(ws + WS_WGU); bf16_t* WD = (bf16_t*)(ws + WS_WD);
    bf16_t* A0 = (bf16_t*)(ws + WS_A0); bf16_t* A1 = (bf16_t*)(ws + WS_A1); bf16_t* A2 = (bf16_t*)(ws + WS_A2); bf16_t* A3 = (bf16_t*)(ws + WS_A3); bf16_t* A4 = (bf16_t*)(ws + WS_A4); bf16_t* A5 = (bf16_t*)(ws + WS_A5);
    bf16_t* D0 = (bf16_t*)(dob + DO_D0); bf16_t* D1 = (bf16_t*)(dob + DO_D1);
    bf16_t* H = D0;
    bf16_t* XA = A0; bf16_t* GGA = A1; bf16_t* SA = A2; bf16_t* SB = A3;
    bf16_t* CQ = (bf16_t*)(dob + DO_CQ); bf16_t* CKV = (bf16_t*)(dob + DO_CKV); bf16_t* KRP = (bf16_t*)(dob + DO_KRP); bf16_t* KR = (bf16_t*)(dob + DO_KR); bf16_t* QR = (bf16_t*)(dob + DO_QR);
    bf16_t* XC = WIN;
    bf16_t* QN = A4; bf16_t* KN = A5; bf16_t* VV = D0; bf16_t* YB = A4; bf16_t* T2 = A3;
    bf16_t* RF = D0; bf16_t* BTF = D1; bf16_t* RB = A0; bf16_t* BTB = A5;
    bf16_t* YA = A4; bf16_t* MRG = A3; bf16_t* XS = A0; bf16_t* MQ = A2; bf16_t* MO = A2 + (size_t)M * 1024; bf16_t* ACT = A3;
    float* PART1 = (float*)(ws + WS_PART1); float* PART2 = (float*)(ws + WS_PART2); float* INV1 = INVQ; float* INV2 = INVKV;

    if (IN(0)) {
        LAS unsigned* tile = (LAS unsigned*)(F.lds + F.wave * 16384);
        const int lane = FLANE;
        int base = 0;
#define CVT_JOB(SRC, LD, KK, NSRC, DST, MAP, KS) do { const int nblk_ = (NSRC) / 64, nit_ = ((KK) / 64) * nblk_; \
            for (int it = (gw - base % NGW + NGW) % NGW; it < nit_; it += NGW) cvt_item64((const float*)(SRC), (LD), (KK), nblk_, (DST), (MAP), 0, (KS), tile, it, lane); base += nit_; } while (0)
        CVT_JOB(args.in[4], IN_COLS, DM, IN_COLS, WIN, MAP_IN, nullptr);
        CVT_JOB(args.in[18], 6144, 1024, 6144, WUQ, MAP_UQ, (const float*)args.in[17]);
        CVT_JOB(args.in[20], 8192, 512, 8192, WUKV, MAP_UKV, (const float*)args.in[19]);
        CVT_JOB(args.in[27], 2048, DM, 2048, WMKV, MAP_MKV, nullptr);
#undef CVT_JOB
        for (int it = (gw - base % NGW + NGW) % NGW; it < 64 * 16; it += NGW) { const int mat = it >> 4, sub = it & 15, mi = mat >> 4, head = mat & 15, dir = mi >> 1, gate = mi & 1, nb = sub & 3;
            const float* w = (const float*)args.in[dir ? (gate ? 14 : 12) : (gate ? 9 : 7)] + (size_t)head * 65536;
            cvt_item64(w, 256, 256, 4, WG, MAP_ID, dir * 8192 + head * 512 + (nb >> 1) * 256 + gate * 128 + (nb & 1) * 64 - nb * 64, nullptr, tile, sub, lane); }
        for (size_t i = (size_t)blockIdx.x * 512 + FTID; i < (size_t)(IN_PAD - IN_COLS) * DM / 8; i += (size_t)F.G * 512) ((GAS u32x4*)(WIN + (size_t)IN_COLS * DM))[i] = (u32x4){0u, 0u, 0u, 0u};
        rms_rows<false>(F, x, (const float*)args.in[3], H, M);
        rms_rows<false>(F, (const float*)args.in[1], (const float*)args.in[25], HM, BATCH * 256);
        const int* pos = (const int*)args.in[2];
        for (int i = blockIdx.x * (NWAVES * 64) + FTID; i < M * 32; i += F.G * NWAVES * 64) {
            const int row = i >> 5, j = i & 31; const float ang = (float)pos[row] * INV_FREQ[j];
            const double t = (double)ang * 0.15915494309189535; const float fr = (float)(t - floor(t));
            CS[2 * (size_t)i] = __builtin_amdgcn_cosf(fr); CS[2 * (size_t)i + 1] = __builtin_amdgcn_sinf(fr);
        }
        for (int i = blockIdx.x * (NWAVES * 64) + FTID; i < 2 * DM; i += F.G * NWAVES * 64) {
            const float lam = ((const float*)args.in[i < DM ? 11 : 16])[i & (DM - 1)];
            C2[i] = -8.0f * log1pf(expf(-lam)) * 1.4426950408889634f;
            const int c = i & (DM - 1);
            if (i < DM) { C2[2 * DM + c] = ((const float*)args.in[8])[c]; C2[3 * DM + c] = ((const float*)args.in[10])[c]; }
            else { C2[4 * DM + c] = ((const float*)args.in[13])[c]; C2[5 * DM + c] = ((const float*)args.in[15])[c]; }
        }
    }
    SEAM(0);
    if (IN(1)) {
        { pg8::Gemm g{H, WIN, M, IN_PAD, DM, DM, DM, 0, 0}; pg8::StaticOrder S; S.init(M, IN_PAD, F.G, (int)blockIdx.x);
          pg8::EpiInProj E{XA, GGA, SA, SB, CQ, CKV, KRP};
          pg8::gemm_phase<pg8::EpiInProj>(F.lds, g, S, E, F.wave); }
        { pg8::Gemm g{HM, WMKV, 512, 2048, DM, DM, DM, 0, 0}; pg8::StaticOrder S; S.init(512, 2048, F.G, (int)((blockIdx.x + 64) % F.G));
          pg8::EpiSplit E{MK, MV, 4, 1024, nullptr};
          pg8::gemm_phase<pg8::EpiSplit>(F.lds, g, S, E, F.wave); }
    }
    SEAM(1);
    if (IN(2)) {
        for (int m = gw; m < M; m += NGW) {
            const GAS u32x4* cq = (const GAS u32x4*)(CQ + (size_t)m * 1024) + FLANE; float s = 0.f;
#pragma unroll
            for (int j = 0; j < 2; ++j) { const u32x4 w = cq[64 * j]; float a;
                a = bf_lo(w.x); s += a * a; a = bf_hi(w.x); s += a * a; a = bf_lo(w.y); s += a * a; a = bf_hi(w.y); s += a * a;
                a = bf_lo(w.z); s += a * a; a = bf_hi(w.z); s += a * a; a = bf_lo(w.w); s += a * a; a = bf_hi(w.w); s += a * a; }
            s = wave_sum(s);
            float s2 = 0.f; { const u32x4 w = ((const GAS u32x4*)(CKV + (size_t)m * 512))[FLANE]; float a;
                a = bf_lo(w.x); s2 += a * a; a = bf_hi(w.x); s2 += a * a; a = bf_lo(w.y); s2 += a * a; a = bf_hi(w.y); s2 += a * a;
                a = bf_lo(w.z); s2 += a * a; a = bf_hi(w.z); s2 += a * a; a = bf_lo(w.w); s2 += a * a; a = bf_hi(w.w); s2 += a * a; }
            s2 = wave_sum(s2);
            if (FLANE == 0) { INVQ[m] = (0.07216878364870322f * 1.4426950408889634f) / sqrtf(s * (1.f / 1024.f) + EPS); INVKV[m] = 1.0f / sqrtf(s2 * (1.f / 512.f) + EPS); }
            if (FLANE < 32) { const float t1 = bf2f(KRP[(size_t)m * 64 + FLANE]), t2 = bf2f(KRP[(size_t)m * 64 + 32 + FLANE]);
                const float c = CS[((size_t)m * 32 + FLANE) * 2], sn = CS[((size_t)m * 32 + FLANE) * 2 + 1];
                ((GAS unsigned*)(KR + (size_t)m * 64))[FLANE] = cvt_pk_bf16(t1 * c - t2 * sn, t2 * c + t1 * sn); }
        }
        { const int seg = gw & 7, lane = FLANE, ch0 = seg * 512 + lane * 8; const float* cw = (const float*)args.in[5]; const float* cb = (const float*)args.in[6];
          float w[4][8], bsv[8];
#pragma unroll
          for (int k = 0; k < 4; ++k)
#pragma unroll
              for (int i = 0; i < 8; ++i) w[k][i] = cw[k * DM + ch0 + i];
#pragma unroll
          for (int i = 0; i < 8; ++i) bsv[i] = cb[ch0 + i];
          for (int rb = gw >> 3; rb < M / 64; rb += NGW >> 3) { const int r0 = rb * 64, s0 = r0 & (SEQ - 1);
              const u32x4 z4 = {0u, 0u, 0u, 0u};
              u32x4 pm2 = s0 >= 2 ? *(const GAS u32x4*)(XA + (size_t)(r0 - 2) * DM + ch0) : z4, pm1 = s0 >= 1 ? *(const GAS u32x4*)(XA + (size_t)(r0 - 1) * DM + ch0) : z4;
              u32x4 cur = *(const GAS u32x4*)(XA + (size_t)r0 * DM + ch0);
              for (int t0 = 0; t0 < 64; t0 += 8) { u32x4 nx[8];
#pragma unroll
                  for (int i = 0; i < 8; ++i) { const int s = s0 + t0 + i + 1; nx[i] = s < SEQ ? *(const GAS u32x4*)(XA + (size_t)(r0 + t0 + i + 1) * DM + ch0) : z4; }
#pragma unroll
                  for (int i = 0; i < 8; ++i) { const u32x4 tp[4] = {pm2, pm1, cur, nx[i]}; float o[8];
#pragma unroll
                      for (int c = 0; c < 8; ++c) o[c] = bsv[c];
#pragma unroll
                      for (int k = 0; k < 4; ++k) { const u32x4 v = tp[k];
                          o[0] += w[k][0] * bf_lo(v.x); o[1] += w[k][1] * bf_hi(v.x); o[2] += w[k][2] * bf_lo(v.y); o[3] += w[k][3] * bf_hi(v.y);
                          o[4] += w[k][4] * bf_lo(v.z); o[5] += w[k][5] * bf_hi(v.z); o[6] += w[k][6] * bf_lo(v.w); o[7] += w[k][7] * bf_hi(v.w); }
                      u32x4 ow; ow.x = cvt_pk_bf16(o[0], o[1]); ow.y = cvt_pk_bf16(o[2], o[3]); ow.z = cvt_pk_bf16(o[4], o[5]); ow.w = cvt_pk_bf16(o[6], o[7]);
                      *(GAS u32x4*)(XC + (size_t)(r0 + t0 + i) * DM + ch0) = ow;
                      pm2 = pm1; pm1 = cur; cur = nx[i]; } } } }
    }
    SEAM(2);
    if (IN(3)) {
        { pg8::Gemm g{CQ, WUQ, M, 6144, 1024, 1024, 1024, 0, 0}; pg8::StaticOrder S; S.init(M, 6144, F.G, (int)blockIdx.x);
          pg8::EpiQ E{QN, QR, INVQ, CS};
          pg8::gemm_phase<pg8::EpiQ>(F.lds, g, S, E, F.wave); }
        { pg8::Gemm g{CKV, WUKV, M, 8192, 512, 512, 512, 0, 0}; pg8::StaticOrder S; S.init(M, 8192, F.G, (int)blockIdx.x);
          pg8::EpiSplit E{KN, VV, 16, DM, INVKV};
          pg8::gemm_phase<pg8::EpiSplit>(F.lds, g, S, E, F.wave); }
    }
    SEAM(3);
    if (IN(4)) {
        const int ndef4 = TAILCVT ? NDEF - 11008 : NDEF;
        const int nunits = BATCH * NH * (SEQ / 256), nslots = (nunits + F.G - 1) / F.G, ips = (ndef4 + NGW * nslots - 1) / (NGW * nslots); int slot = 0;
        for (int L = F.vcu; L < nunits; L += F.G, ++slot) {
            const int bh = L >> 5, qb = L & 31, b = bh >> 5, h = bh & 31; const size_t r0 = (size_t)b * SEQ + (size_t)qb * 256, k0 = (size_t)b * SEQ;
            att::attn_unit_dma<att::Cfg<2, 1, 3, 0, DM, 2048, DM, 64, DM, DM, SEQ>>(QN + r0 * DM + h * 128, QR + r0 * 2048 + h * 64, KN + k0 * DM + h * 128, KR + k0 * 64,
                                       VV + k0 * DM + h * 128, YB + r0 * DM + h * 128, 8.0f * 1.4426950408889634f, (char*)lds, F.lds, F.wave);
            __syncthreads();
            { LAS unsigned* tile = (LAS unsigned*)(F.lds + F.wave * 16384); const int lane = FLANE;
              for (int i = 0; i < ips; ++i) { const int u = gw + NGW * (slot * ips + i); if (u < ndef4) cvt_deferred(args, ws, (TAILCVT && u >= 22016) ? u + 11008 : u, tile, lane); } }
        }
        __syncthreads();
    }
    SEAM(4);
    if (IN(5)) {
        { pg8::Gemm g{YB, WPM, M, DM, DM, DM, DM, 0, 0}; pg8::StaticOrder S; S.init(M, DM, F.G, (int)blockIdx.x);
          pg8::EpiGateMul<false> E{SB, T2};
          pg8::gemm_phase<pg8::EpiGateMul<false>>(F.lds, g, S, E, F.wave); }
        { pg8::Gemm g{XC, WG, M, 16384, 256, DM, 256, 1, 15}; pg8::StaticOrder S; S.init(M, 16384, F.G, (int)blockIdx.x);
          pg8::EpiGates E{XC, ws, dob, C2};
          pg8::gemm_phase<pg8::EpiGates>(F.lds, g, S, E, F.wave); }
    }
    SEAM(5);
    if (IN(6)) {
        const int lane = FLANE;
        for (int it = gw; it < 2 * BATCH * SCAN_NC * 16; it += NGW) {
            const int chg = it & 15, ck = (it >> 4) & (SCAN_NC - 1), b = (it >> 10) & 1, dir = it >> 11, ch = chg * 256 + lane * 4;
            const bf16_t* Rp = dir ? RB : RF; const bf16_t* Bp = dir ? BTB : BTF;
            const f32x4 cc = *(const GAS f32x4*)(C2 + dir * DM + ch);
            f32x4 P = {1.f, 1.f, 1.f, 1.f}, hh = {0.f, 0.f, 0.f, 0.f};
            const size_t rowb = (size_t)b * SEQ + (size_t)ck * SCAN_L;
            const bool head = dir ? ck == SCAN_NC - 1 : ck == 0;
            for (int t0 = 0; t0 < SCAN_L; t0 += 16) { u32x2 rw[16], bw[16];
#pragma unroll
                for (int i = 0; i < 16; ++i) { const size_t row = rowb + (dir ? SCAN_L - 1 - (t0 + i) : t0 + i); rw[i] = *(const GAS u32x2*)(Rp + row * DM + ch); bw[i] = *(const GAS u32x2*)(Bp + row * DM + ch); }
#pragma unroll
                for (int i = 0; i < 16; ++i) {
                    f32x4 a; a.x = __builtin_amdgcn_exp2f(cc.x * bf_lo(rw[i].x)); a.y = __builtin_amdgcn_exp2f(cc.y * bf_hi(rw[i].x)); a.z = __builtin_amdgcn_exp2f(cc.z * bf_lo(rw[i].y)); a.w = __builtin_amdgcn_exp2f(cc.w * bf_hi(rw[i].y));
                    f32x4 bt = {bf_lo(bw[i].x), bf_hi(bw[i].x), bf_lo(bw[i].y), bf_hi(bw[i].y)};
                    if (!(head && t0 == 0 && i == 0)) bt = bt * mult_of(a);
                    P = P * a; hh = a * hh + bt; } }
            GAS f32x4* ag = (GAS f32x4*)(AGG + ((((size_t)dir * BATCH + b) * SCAN_NC + ck) * DM + ch) * 2);
            ag[0] = (f32x4){P.x, hh.x, P.y, hh.y}; ag[1] = (f32x4){P.z, hh.z, P.w, hh.w};
        }
    }
    SEAM(6);
    if (IN(7)) {
        const int lane = FLANE;
        for (int it = gw; it < BATCH * SCAN_NC * 16; it += NGW) {
            const int chg = it & 15, ck = (it >> 4) & (SCAN_NC - 1), b = it >> 10, ch = chg * 256 + lane * 4;
            f32x4 cf = {0.f, 0.f, 0.f, 0.f}, cbk = {0.f, 0.f, 0.f, 0.f};
            for (int k = 0; k < ck; ++k) { const GAS f32x4* ag = (const GAS f32x4*)(AGG + ((((size_t)0 * BATCH + b) * SCAN_NC + k) * DM + ch) * 2); const f32x4 u0 = ag[0], u1 = ag[1];
                cf.x = u0.x * cf.x + u0.y; cf.y = u0.z * cf.y + u0.w; cf.z = u1.x * cf.z + u1.y; cf.w = u1.z * cf.w + u1.w; }
            for (int k = SCAN_NC - 1; k > ck; --k) { const GAS f32x4* ag = (const GAS f32x4*)(AGG + ((((size_t)1 * BATCH + b) * SCAN_NC + k) * DM + ch) * 2); const f32x4 u0 = ag[0], u1 = ag[1];
                cbk.x = u0.x * cbk.x + u0.y; cbk.y = u0.z * cbk.y + u0.w; cbk.z = u1.x * cbk.z + u1.y; cbk.w = u1.z * cbk.w + u1.w; }
            const f32x4 ccf = *(const GAS f32x4*)(C2 + ch), ccb = *(const GAS f32x4*)(C2 + DM + ch);
            const size_t rowb = (size_t)b * SEQ + (size_t)ck * SCAN_L;
            f32x4 hh = cbk;
            for (int t0 = SCAN_L - 16; t0 >= 0; t0 -= 16) { u32x2 rw[16], bw[16];
#pragma unroll
                for (int i = 0; i < 16; ++i) { const size_t row = rowb + t0 + 15 - i; rw[i] = *(const GAS u32x2*)(RB + row * DM + ch); bw[i] = *(const GAS u32x2*)(BTB + row * DM + ch); }
#pragma unroll
                for (int i = 0; i < 16; ++i) { const size_t row = rowb + t0 + 15 - i;
                    f32x4 a; a.x = __builtin_amdgcn_exp2f(ccb.x * bf_lo(rw[i].x)); a.y = __builtin_amdgcn_exp2f(ccb.y * bf_hi(rw[i].x)); a.z = __builtin_amdgcn_exp2f(ccb.z * bf_lo(rw[i].y)); a.w = __builtin_amdgcn_exp2f(ccb.w * bf_hi(rw[i].y));
                    f32x4 bt = {bf_lo(bw[i].x), bf_hi(bw[i].x), bf_lo(bw[i].y), bf_hi(bw[i].y)};
                    if (!(ck == SCAN_NC - 1 && t0 == SCAN_L - 16 && i == 0)) bt = bt * mult_of(a);
                    hh = a * hh + bt;
                    u32x2 ow; ow.x = cvt_pk_bf16(hh.x, hh.y); ow.y = cvt_pk_bf16(hh.z, hh.w); *(GAS u32x2*)(YA + row * DM + ch) = ow; } }
            VM_WAIT();
            hh = cf;
            for (int t0 = 0; t0 < SCAN_L; t0 += 8) { u32x2 rw[8], bw[8], yw[8], gg2[8];
#pragma unroll
                for (int i = 0; i < 8; ++i) { const size_t row = rowb + t0 + i; rw[i] = *(const GAS u32x2*)(RF + row * DM + ch); bw[i] = *(const GAS u32x2*)(BTF + row * DM + ch);
                    yw[i] = *(const GAS u32x2*)(YA + row * DM + ch); gg2[i] = *(const GAS u32x2*)(GGA + row * DM + ch); }
#pragma unroll
                for (int i = 0; i < 8; ++i) { const size_t row = rowb + t0 + i;
                    f32x4 a; a.x = __builtin_amdgcn_exp2f(ccf.x * bf_lo(rw[i].x)); a.y = __builtin_amdgcn_exp2f(ccf.y * bf_hi(rw[i].x)); a.z = __builtin_amdgcn_exp2f(ccf.z * bf_lo(rw[i].y)); a.w = __builtin_amdgcn_exp2f(ccf.w * bf_hi(rw[i].y));
                    f32x4 bt = {bf_lo(bw[i].x), bf_hi(bw[i].x), bf_lo(bw[i].y), bf_hi(bw[i].y)};
                    if (!(ck == 0 && t0 == 0 && i == 0)) bt = bt * mult_of(a);
                    hh = a * hh + bt;
                    const f32x4 hb = {bf_lo(yw[i].x), bf_hi(yw[i].x), bf_lo(yw[i].y), bf_hi(yw[i].y)}, gg = {bf_lo(gg2[i].x), bf_hi(gg2[i].x), bf_lo(gg2[i].y), bf_hi(gg2[i].y)};
                    const f32x4 y = gg * (hh + hb);
                    u32x2 ow; ow.x = cvt_pk_bf16(y.x, y.y); ow.y = cvt_pk_bf16(y.z, y.w); *(GAS u32x2*)(YA + row * DM + ch) = ow; } }
        }
    }
    SEAM(7);
    if (IN(8)) {
        pg8::Gemm g{YA, WPL, M, DM, DM, DM, DM, 0, 0}; pg8::StaticOrder S; S.init(M, DM, F.G, (int)blockIdx.x);
        pg8::EpiGateMul<true> E{SA, MRG};
        pg8::gemm_phase<pg8::EpiGateMul<true>>(F.lds, g, S, E, F.wave);
    }
    SEAM(8);
    if (IN(9)) {
        pg8::Gemm g{MRG, WO, M, DM, DM, DM, DM, 0, 0}; pg8::StaticOrder S; S.init(M, DM, F.G, (int)blockIdx.x);
        pg8::EpiResidBf<true, true> E{x, XS, PART1};
        pg8::gemm_phase<pg8::EpiResidBf<true, true>>(F.lds, g, S, E, F.wave);
    }
    SEAM(9);
    if (IN(10)) inv_rows(F, PART1, INV1, 0.0625f * 1.4426950408889634f);
    SEAM(10);
    if (IN(11)) {
        pg8::Gemm g{XS, WMQ, M, 1024, DM, DM, DM, 0, 0}; pg8::StaticOrder S; S.init(M, 1024, F.G, (int)blockIdx.x);
        pg8::EpiSplit E{MQ, MQ, 1 << 20, 1024, INV1};
        pg8::gemm_phase<pg8::EpiSplit>(F.lds, g, S, E, F.wave);
    }
    SEAM(11);
    if (IN(12)) {
        for (int L = F.vcu; L < BATCH * 4 * 2 * (SEQ / 256); L += F.G) {
            const int grp = L >> 5, qb = L & 31, b = grp >> 3, mh = (grp >> 1) & 3, vh = grp & 1; const size_t r0 = (size_t)b * SEQ + (size_t)qb * 256, k0 = (size_t)b * 256;
            att::attn_unit<att::Cfg<4, 0, 0, 0, 1024, 1024, 1024, 1024, 1024, 1024, 256>>(MQ + r0 * 1024 + mh * 256, MQ, MK + k0 * 1024 + mh * 256, MK,
                                        MV + k0 * 1024 + mh * 256 + vh * 128, MO + r0 * 1024 + mh * 256 + vh * 128, 8.0f * 1.4426950408889634f, (char*)lds, F.wave);
        }
        __syncthreads();
    }
    SEAM(12);
    if (IN(13)) {
        pg8::Gemm g{MO, WMO, M, DM, 1024, 1024, 1024, 0, 0}; pg8::StaticOrder S; S.init(M, DM, F.G, (int)blockIdx.x);
        pg8::EpiResidBf<false, true> E{nullptr, XS, PART2};
        pg8::gemm_phase<pg8::EpiResidBf<false, true>>(F.lds, g, S, E, F.wave);
    }
    SEAM(13);
    if (IN(14)) inv_rows(F, PART2, INV2, 1.f);
    SEAM(14);
    if (IN(15)) {
        pg8::Gemm g{XS, WGU, M, 2 * DFF, DM, DM, DM, 0, 0}; pg8::StaticOrder S; S.init(M, 2 * DFF, F.G, (int)blockIdx.x);
        pg8::EpiSwiglu E{ACT, INV2};
        pg8::gemm_phase<pg8::EpiSwiglu>(F.lds, g, S, E, F.wave);
        if (TAILCVT && (int)blockIdx.x >= SWI_UNITS % F.G) {
            __syncthreads();
            LAS unsigned* tile = (LAS unsigned*)(F.lds + F.wave * 16384); const int lane = FLANE, rem = SWI_UNITS % F.G, nw = (F.G - rem) * NWAVES;
            for (int it = ((int)blockIdx.x - rem) * NWAVES + F.wave; it < 11008; it += nw) cvt_deferred(args, ws, 22016 + it, tile, lane); }
    }
    SEAM(15);
    if (IN(16)) {
        pg8::Gemm g{ACT, WD, M, DM, DFF, DFF, DFF, 0, 0}; pg8::StaticOrder S; S.init(M, DM, F.G, (int)blockIdx.x);
        pg8::EpiResidBf<false, false> E{nullptr, XS, nullptr};
        pg8::gemm_phase<pg8::EpiResidBf<false, false>>(F.lds, g, S, E, F.wave);
    }
    SEAM(16);
    if (IN(17)) rms_rows_bf(F, XS, (const float*)args.in[33], args.out, M);
#undef IN
#undef SEAM
}

extern "C" void kernel_launch(void* const* d_in, const int* in_sizes, int n_in, void* d_out, int out_size, void* d_ws, size_t ws_size, hipStream_t stream) {
    static int grid = 0;
    if (grid == 0) {
        if (n_in != 34 || in_sizes[0] != M * DM || out_size != M * DM || ws_size < WS_END) {
            fprintf(stderr, "kernel_launch: shape/workspace mismatch: n_in %d in0 %d out %d ws %zu (need %zu); nothing launched\n", n_in, n_in > 0 ? in_sizes[0] : -1, out_size, ws_size, (size_t)WS_END);
            grid = -1; return; }
        int dev = 0, cus = 0, per_cu = 0;
        if (hipGetDevice(&dev) != hipSuccess || hipDeviceGetAttribute(&cus, hipDeviceAttributeMultiprocessorCount, dev) != hipSuccess) { grid = -1; return; }
        if (hipFuncSetAttribute((const void*)mk_fwd, hipFuncAttributeMaxDynamicSharedMemorySize, LDS_BYTES) != hipSuccess) { fprintf(stderr, "kernel_launch: hipFuncSetAttribute failed\n"); grid = -1; return; }
        if (hipOccupancyMaxActiveBlocksPerMultiprocessor(&per_cu, (const void*)mk_fwd, NWAVES * 64, LDS_BYTES) != hipSuccess || per_cu < 1)
            fprintf(stderr, "kernel_launch: note: occupancy query reports %d workgroups per CU\n", per_cu);
        (void)hipGetLastError();
        grid = cus;
    }
    if (grid < 0) return;
    if (hipMemsetAsync((char*)d_ws + WS_CTL, 0, CTL_ZERO_BYTES, stream) != hipSuccess) { fprintf(stderr, "kernel_launch: memset failed\n"); return; }
    Args a{};
    for (int i = 0; i < 34; ++i) a.in[i] = d_in[i];
    a.out = (float*)d_out; a.ws = (unsigned char*)d_ws;
#if MK_PER_PHASE
    for (int p = 0; p < NPHASE; ++p) { a.ph_lo = p; a.ph_hi = p + 1; hipLaunchKernelGGL(mk_fwd, dim3(grid), dim3(NWAVES * 64), LDS_BYTES, stream, a); }
#else
    a.ph_lo = 0; a.ph_hi = NPHASE; hipLaunchKernelGGL(mk_fwd, dim3(grid), dim3(NWAVES * 64), LDS_BYTES, stream, a);
#endif
    const hipError_t le = hipPeekAtLastError();
    if (le != hipSuccess) fprintf(stderr, "kernel_launch: launch failed: %s\n", hipGetErrorName(le));
}
```
